# Optimizing an MI355X kernel written in HIP

```python
import math
import jax
import jax.numpy as jnp
from jax import lax
import numpy as np


D_MODEL = 1024
BATCH = 32
SEQ = 2048
DEPTH = 2

CHUNK = 64
D_MIX = D_MODEL
HEAD_DIM = 64
D_RWKV = D_MIX // 2
D_SB = D_MIX - D_RWKV
H_RWKV = D_RWKV // HEAD_DIM
H_SB = D_SB // HEAD_DIM
DECAY_LORA = 64
ICLR_LORA = 64
GATE_LORA = 128
VRES_LORA = 32
C_RWKV = 3 * D_RWKV + DECAY_LORA + ICLR_LORA + GATE_LORA
C_IN = C_RWKV + 3 * D_SB
SB_BLOCK = 128
N_EXPERTS = 32
TOP_K = 4
D_FF_EXPERT = D_MODEL
SWIGLU_ALPHA = 1.702
SWIGLU_LIMIT = 7.0
MOE_BLOCK = 128
NORM_EPS = 1e-6
GN_EPS = 1e-5 * HEAD_DIM
L2_EPS = 1e-12

kernel_name = 'hybrid_rwkv7_stickbreak_moe_adaln'


def rms_norm(x, g):
    xf = x.astype(jnp.float32)
    y = xf * lax.rsqrt(jnp.mean(jnp.square(xf), axis=-1, keepdims=True) + NORM_EPS)
    return (y * g.astype(jnp.float32)).astype(x.dtype)


def token_shift(z, mu):
    z_prev = jnp.pad(z[:, :-1], ((0, 0), (1, 0), (0, 0)))
    return z + (z_prev - z) * mu


def split_heads(t, n_heads):
    bsz, seq, _ = t.shape
    return t.reshape(bsz, seq, n_heads, HEAD_DIM)


def rwkv7_recurrence(r, decay, k, v, kk, a):
    bsz, seq, nh, hd = r.shape
    n_chunks = seq // CHUNK

    def to_chunks(t):
        return jnp.transpose(t, (1, 0, 2, 3)).reshape(n_chunks, CHUNK, bsz, nh, hd)

    def step(state, inp):
        r_t, w_t, k_t, v_t, kk_t, a_t = inp
        s_kk = jnp.einsum('bhvk,bhk->bhv', state, kk_t)
        state = (state * w_t[:, :, None, :]
                 - s_kk[..., None] * (kk_t * a_t)[:, :, None, :]
                 + v_t[..., None] * k_t[:, :, None, :])
        return state, jnp.einsum('bhvk,bhk->bhv', state, r_t)

    def chunk_step(state, chunk):
        return lax.scan(step, state, chunk)

    s0 = jnp.zeros((bsz, nh, hd, hd), jnp.float32)
    xs = tuple(to_chunks(t) for t in (r, decay, k, v, kk, a))
    _, y = lax.scan(chunk_step, s0, xs)
    return jnp.transpose(y.reshape(seq, bsz, nh, hd), (1, 0, 2, 3))


def rwkv7_time_mix(z, v_first, mu, decay_w0, decay_up, iclr_a0, iclr_up, gate_up,
                   k_k, k_a, r_k, lnx_w, lnx_b, vres):
    bsz, seq, _ = z.shape
    zs = token_shift(z, mu)
    r = zs[..., :D_RWKV]
    k = zs[..., D_RWKV:2 * D_RWKV]
    v = zs[..., 2 * D_RWKV:3 * D_RWKV]
    o = 3 * D_RWKV
    w_lo = zs[..., o:o + DECAY_LORA]
    a_lo = zs[..., o + DECAY_LORA:o + DECAY_LORA + ICLR_LORA]
    g_lo = zs[..., o + DECAY_LORA + ICLR_LORA:]
    w_pre = (decay_w0 + jnp.tanh(w_lo) @ decay_up).astype(jnp.float32)
    log_decay = -jnp.exp(-jax.nn.softplus(-w_pre) - 0.5)
    a = jax.nn.sigmoid(iclr_a0 + a_lo @ iclr_up)
    g = jax.nn.sigmoid(g_lo) @ gate_up
    if vres is None:
        v_first = v
    else:
        vres_down, vres_up, vres_b = vres
        v = v + (v_first - v) * jax.nn.sigmoid(vres_b + (v @ vres_down) @ vres_up)
    kk = split_heads((k * k_k).astype(jnp.float32), H_RWKV)
    kk = kk / jnp.maximum(jnp.sqrt(jnp.sum(jnp.square(kk), axis=-1, keepdims=True)), L2_EPS)
    k = k * (1.0 + (a - 1.0) * k_a)
    rh = split_heads(r.astype(jnp.float32), H_RWKV)
    kh = split_heads(k.astype(jnp.float32), H_RWKV)
    vh = split_heads(v.astype(jnp.float32), H_RWKV)
    ah = split_heads(a.astype(jnp.float32), H_RWKV)
    wh = split_heads(jnp.exp(log_decay), H_RWKV)
    y = rwkv7_recurrence(rh, wh, kh, vh, kk, ah)
    mean = jnp.mean(y, axis=-1, keepdims=True)
    var = jnp.mean(jnp.square(y - mean), axis=-1, keepdims=True)
    y = ((y - mean) * lax.rsqrt(var + GN_EPS)).reshape(bsz, seq, D_RWKV)
    y = y * lnx_w.astype(jnp.float32) + lnx_b.astype(jnp.float32)
    bonus = jnp.sum(rh * kh * r_k.astype(jnp.float32), axis=-1, keepdims=True) * vh
    out = (y + bonus.reshape(bsz, seq, D_RWKV)) * g.astype(jnp.float32)
    return out.astype(z.dtype), v_first


def stick_breaking_attention(q, k, v, q_norm_g, k_norm_g, out_g):
    bsz, seq, _ = q.shape
    qh = jnp.transpose(rms_norm(split_heads(q, H_SB), q_norm_g).astype(jnp.float32), (0, 2, 1, 3))
    kh = jnp.transpose(rms_norm(split_heads(k, H_SB), k_norm_g).astype(jnp.float32), (0, 2, 1, 3))
    vh = jnp.transpose(split_heads(v, H_SB).astype(jnp.float32), (0, 2, 1, 3))
    scale = 1.0 / math.sqrt(HEAD_DIM)
    blocks = []
    for blk in range(seq // SB_BLOCK):
        t0 = blk * SB_BLOCK
        t1 = t0 + SB_BLOCK
        logits = jnp.einsum('bhqd,bhkd->bhqk', qh[:, :, t0:t1], kh[:, :, :t1]) * scale
        mask = jnp.arange(t1)[None, :] < jnp.arange(t0, t1)[:, None]
        log_keep = jnp.where(mask, jax.nn.log_sigmoid(-logits), 0.0)
        log_between = lax.cumsum(log_keep, axis=3, reverse=True) - log_keep
        weight = jnp.where(mask, jnp.exp(jax.nn.log_sigmoid(logits) + log_between), 0.0)
        blocks.append(jnp.einsum('bhqk,bhkd->bhqd', weight, vh[:, :, :t1]))
    o = jnp.transpose(jnp.concatenate(blocks, axis=2), (0, 2, 1, 3))
    o = rms_norm(o, out_g.reshape(H_SB, HEAD_DIM))
    return o.reshape(bsz, seq, D_SB).astype(q.dtype)


def moe_ffn(h, router_w, router_b, w1, b1, w2, b2):
    bsz, seq, d = h.shape
    n_tok = bsz * seq
    xt = h.reshape(n_tok, d)
    logits = xt.astype(jnp.float32) @ router_w.astype(jnp.float32) + router_b.astype(jnp.float32)
    top_logit, top_idx = lax.top_k(logits, TOP_K)
    top_gate = jax.nn.softmax(top_logit, axis=-1)
    n_assign = n_tok * TOP_K
    flat_e = top_idx.reshape(-1)
    flat_tok = jnp.arange(n_assign, dtype=jnp.int32) // TOP_K
    order = jnp.argsort(flat_e, stable=True)
    e_sorted = flat_e[order]
    counts = jnp.bincount(flat_e, length=N_EXPERTS)
    padded = (counts + MOE_BLOCK - 1) // MOE_BLOCK * MOE_BLOCK
    padded_end = jnp.cumsum(padded)
    padded_start = padded_end - padded
    start = jnp.cumsum(counts) - counts
    dest = padded_start[e_sorted] + jnp.arange(n_assign, dtype=jnp.int32) - start[e_sorted]
    n_rows = n_assign + N_EXPERTS * MOE_BLOCK
    n_blocks = n_rows // MOE_BLOCK
    row_tok = jnp.zeros((n_rows,), jnp.int32).at[dest].set(flat_tok[order])
    row_gate = jnp.zeros((n_rows,), h.dtype).at[dest].set(top_gate.reshape(-1)[order].astype(h.dtype))
    block_expert = jnp.minimum(
        jnp.searchsorted(padded_end, jnp.arange(n_blocks, dtype=jnp.int32) * MOE_BLOCK, side='right'),
        N_EXPERTS - 1)

    def expert_block(args):
        tok, gate, e = args
        xb = xt[tok]
        hid = xb @ w1[e] + b1[e]
        glu = jnp.minimum(hid[:, :D_FF_EXPERT], SWIGLU_LIMIT)
        lin = jnp.clip(hid[:, D_FF_EXPERT:], -SWIGLU_LIMIT, SWIGLU_LIMIT)
        act = glu * jax.nn.sigmoid(SWIGLU_ALPHA * glu) * (lin + 1.0)
        return (act @ w2[e] + b2[e]) * gate[:, None]

    y = lax.map(expert_block, (row_tok.reshape(n_blocks, MOE_BLOCK),
                               row_gate.reshape(n_blocks, MOE_BLOCK), block_expert))
    out = jax.ops.segment_sum(y.reshape(n_rows, d), row_tok, num_segments=n_tok)
    return out.reshape(bsz, seq, d)


def setup_inputs(seed: int = 0) -> dict:
    key = jax.random.key(seed)
    ks = iter(jax.random.split(key, 40))

    def normal(shape, scale):
        return jax.random.normal(next(ks), shape, jnp.float32) * scale

    def gain(shape, s=0.02):
        return 1.0 + normal(shape, s)

    L = DEPTH
    LV = max(DEPTH - 1, 0)
    return {
        'x': normal((BATCH, SEQ, D_MODEL), 1.0),
        'c': normal((BATCH, D_MODEL), 1.0),
        'norm1_g': gain((L, D_MODEL)),
        'norm2_g': gain((L, D_MODEL)),
        'ada_w': normal((L, D_MODEL, 6 * D_MODEL), 0.5 * D_MODEL ** -0.5),
        'ada_b': normal((L, 6 * D_MODEL), 0.02),
        'w_in': normal((L, D_MODEL, C_IN), D_MODEL ** -0.5),
        'shift_mu': jax.random.uniform(next(ks), (L, C_RWKV), jnp.float32),
        'decay_w0': jax.random.uniform(next(ks), (L, D_RWKV), jnp.float32, -1.5, 1.5),
        'decay_up': normal((L, DECAY_LORA, D_RWKV), 0.5 * DECAY_LORA ** -0.5),
        'iclr_a0': normal((L, D_RWKV), 0.1),
        'iclr_up': normal((L, ICLR_LORA, D_RWKV), 0.5 * ICLR_LORA ** -0.5),
        'gate_up': normal((L, GATE_LORA, D_RWKV), GATE_LORA ** -0.5),
        'k_k': gain((L, D_RWKV), 0.1),
        'k_a': gain((L, D_RWKV), 0.1),
        'r_k': normal((L, H_RWKV, HEAD_DIM), 0.1),
        'lnx_w': gain((L, D_RWKV)),
        'lnx_b': normal((L, D_RWKV), 0.02),
        'vres_down': normal((LV, D_RWKV, VRES_LORA), D_RWKV ** -0.5),
        'vres_up': normal((LV, VRES_LORA, D_RWKV), 0.5 * VRES_LORA ** -0.5),
        'vres_b': normal((LV, D_RWKV), 0.1),
        'q_norm_g': gain((L, HEAD_DIM)),
        'k_norm_g': gain((L, HEAD_DIM)),
        'sb_out_g': gain((L, D_SB)),
        'w_out': normal((L, D_MIX, D_MODEL), D_MIX ** -0.5),
        'router_w': normal((L, D_MODEL, N_EXPERTS), D_MODEL ** -0.5),
        'router_b': normal((L, N_EXPERTS), 0.01),
        'exp_w1': normal((L, N_EXPERTS, D_MODEL, 2 * D_FF_EXPERT), D_MODEL ** -0.5),
        'exp_b1': normal((L, N_EXPERTS, 2 * D_FF_EXPERT), 0.02),
        'exp_w2': normal((L, N_EXPERTS, D_FF_EXPERT, D_MODEL), D_FF_EXPERT ** -0.5),
        'exp_b2': normal((L, N_EXPERTS, D_MODEL), 0.02),
    }


def reference(x, c, norm1_g, norm2_g, ada_w, ada_b, w_in, shift_mu, decay_w0, decay_up,
              iclr_a0, iclr_up, gate_up, k_k, k_a, r_k, lnx_w, lnx_b, vres_down, vres_up,
              vres_b, q_norm_g, k_norm_g, sb_out_g, w_out, router_w, router_b,
              exp_w1, exp_b1, exp_w2, exp_b2):
    cond = jax.nn.silu(c)
    v_first = None
    for l in range(DEPTH):
        mod = cond @ ada_w[l] + ada_b[l]
        shift1, scale1, gate1, shift2, scale2, gate2 = jnp.split(mod[:, None, :], 6, axis=-1)
        h = rms_norm(x, norm1_g[l]) * (1.0 + scale1) + shift1
        z = h @ w_in[l]
        vres = None if l == 0 else (vres_down[l - 1], vres_up[l - 1], vres_b[l - 1])
        y_rwkv, v_first = rwkv7_time_mix(
            z[..., :C_RWKV], v_first, shift_mu[l], decay_w0[l], decay_up[l], iclr_a0[l],
            iclr_up[l], gate_up[l], k_k[l], k_a[l], r_k[l], lnx_w[l], lnx_b[l], vres)
        z_sb = z[..., C_RWKV:]
        y_sb = stick_breaking_attention(
            z_sb[..., :D_SB], z_sb[..., D_SB:2 * D_SB], z_sb[..., 2 * D_SB:],
            q_norm_g[l], k_norm_g[l], sb_out_g[l])
        mixed = jnp.concatenate([y_rwkv, y_sb], axis=-1) @ w_out[l]
        x = x + gate1 * mixed
        h2 = rms_norm(x, norm2_g[l]) * (1.0 + scale2) + shift2
        x = x + gate2 * moe_ffn(h2, router_w[l], router_b[l], exp_w1[l], exp_b1[l],
                                exp_w2[l], exp_b2[l])
    return x
```

```cpp
#include <hip/hip_runtime.h>
#include <cstdio>
#include <cstdint>

#ifndef MK_N_LAUNCHES
#define MK_N_LAUNCHES 1
#endif

#define NOPK __attribute__((target("no-packed-fp32-ops")))
#define __uint_as_float(x) __builtin_bit_cast(float, (unsigned)(x))
#define __float_as_uint(x) __builtin_bit_cast(unsigned, (float)(x))
#define __float_as_int(x) __builtin_bit_cast(int, (float)(x))
#define __int_as_float(x) __builtin_bit_cast(float, (int)(x))
#define __syncthreads() do { __builtin_amdgcn_fence(__ATOMIC_RELEASE, "workgroup"); __builtin_amdgcn_s_barrier(); __builtin_amdgcn_fence(__ATOMIC_ACQUIRE, "workgroup"); } while (0)
#define __all(p) (__builtin_amdgcn_ballot_w64(!(p)) == 0ull)
#define atomicAdd(p, v) __hip_atomic_fetch_add((p), (v), __ATOMIC_RELAXED, __HIP_MEMORY_SCOPE_AGENT)
#define __shfl_xor(v, m) shfl_xor_f32((v), (m))
#define GAS __attribute__((address_space(1)))
#define LAS __attribute__((address_space(3)))
typedef unsigned short bf16;
typedef short bf16x8 __attribute__((ext_vector_type(8)));
typedef float f32x2 __attribute__((ext_vector_type(2)));
typedef float f32x4 __attribute__((ext_vector_type(4)));
typedef float f32x16 __attribute__((ext_vector_type(16)));
typedef unsigned u32x2 __attribute__((ext_vector_type(2)));
typedef unsigned u32x4 __attribute__((ext_vector_type(4)));
typedef int i32x4 __attribute__((ext_vector_type(4)));
typedef int i32x8 __attribute__((ext_vector_type(8)));
typedef short s16x4 __attribute__((ext_vector_type(4)));

constexpr int D = 1024, BATCH = 32, SEQ = 2048, M = BATCH * SEQ, DEPTH = 2;
constexpr int HD = 64, DR = 512, NH = 8;
constexpr int C_RWKV = 1792, C_IN = 3328;
constexpr int NE = 32, FF = 1024;
constexpr int ECAP = 65536;
constexpr int NROWS_MAX = M * 4 + NE * 256;
constexpr int NPH = 20;
constexpr float NORM_EPS = 1e-6f, GN_EPS = 1e-5f * 64.f;
constexpr float SB_EXIT = -30.f;

enum { I_X = 0, I_C, I_N1G, I_N2G, I_ADAW, I_ADAB, I_WIN, I_MU, I_DW0, I_DUP, I_IA0, I_IUP, I_GUP, I_KK, I_KA, I_RK, I_LNW, I_LNB, I_VRD, I_VRU, I_VRB,
       I_QG, I_KG, I_SBG, I_WOUT, I_RW, I_RB, I_W1, I_B1, I_W2, I_B2, N_IN };

constexpr size_t MiB = 1u << 20;
constexpr size_t WS_CTL = 0, CTL_ZERO_BYTES = 1 * MiB;
constexpr size_t WS_MOD = 1 * MiB;
constexpr size_t WS_LORA = 3 * MiB;
constexpr size_t LORA_STRIDE = 512 * 1024;
constexpr size_t LO_DUP = 0, LO_IUP = 65536, LO_GUP = 131072, LO_VRD = 262144, LO_VRU = 294912, LO_RWS = 327680;
constexpr size_t WS_WOUT = 4 * MiB;
constexpr size_t WS_WIN = 8 * MiB;
constexpr size_t WS_W1 = 22 * MiB;
constexpr size_t WS_W2 = 278 * MiB;
constexpr size_t WS_VFIRST = 406 * MiB;
constexpr size_t WS_ROWTOK = 470 * MiB;
constexpr size_t WS_TOKSLOT = 478 * MiB;
constexpr size_t WS_TOKGATE = 479 * MiB;
constexpr size_t WS_BON = WS_TOKSLOT;
constexpr size_t WS_H = 480 * MiB;
constexpr size_t WS_T = 608 * MiB;
constexpr size_t WS_Z = WS_T;
constexpr size_t WS_OPS = WS_T + 416 * MiB;
constexpr size_t WS_QN = WS_T + 864 * MiB;
constexpr size_t WS_KN = WS_T + 928 * MiB;
constexpr size_t WS_VF = WS_T + 992 * MiB;
constexpr size_t WS_YCAT = WS_T + 1056 * MiB;
constexpr size_t WS_ACT = WS_T;
constexpr size_t WS_Y = WS_T + 528 * MiB;
constexpr size_t WS_X1 = WS_T + 272 * MiB;
constexpr size_t WS_END = WS_T + 1184 * MiB;
static_assert((size_t)NROWS_MAX * 2048 <= 528 * MiB, "act/y buffers");
static_assert((size_t)NROWS_MAX * 1024 <= 272 * MiB, "e4m3 act rows end below x1");
constexpr int CW_TMO = 0, CW_BAR = 4096, CW_CNT = 16384;

constexpr int RING_BYTES = 131072;
constexpr int XTRA_OFF = RING_BYTES, XTRA_BYTES = 32512;
constexpr int MISC_OFF = XTRA_OFF + XTRA_BYTES;
constexpr int LDS_BYTES = MISC_OFF + 256;
constexpr int TAB_OFF = XTRA_OFF;
constexpr int GOFF_OFF = XTRA_OFF + 4096;

__device__ __forceinline__ NOPK float shfl_xor_f32(float v, int m) { int lane = (int)__builtin_amdgcn_mbcnt_hi(~0u, __builtin_amdgcn_mbcnt_lo(~0u, 0u)); asm volatile("" : "+v"(lane));     return __builtin_bit_cast(float, __builtin_amdgcn_ds_bpermute((lane ^ m) << 2, __builtin_bit_cast(int, v))); }
typedef __bf16 bf16v2_t __attribute__((ext_vector_type(2)));
__device__ __forceinline__ NOPK unsigned cvt_pk_bf16(float lo, float hi) { const f32x2 v = {lo, hi}; return __builtin_bit_cast(unsigned, __builtin_convertvector(v, bf16v2_t)); }
__device__ __forceinline__ NOPK float bflo(unsigned w) { return __uint_as_float(w << 16); }
__device__ __forceinline__ NOPK float bfhi(unsigned w) { return __uint_as_float(w & 0xffff0000u); }
__device__ __forceinline__ NOPK float wave_sum(float v) {
#pragma unroll
    for (int o = 1; o < 64; o <<= 1) v += __shfl_xor(v, o);
    return v;
}
template <int CTRL> __device__ __forceinline__ NOPK float dpp_add(float x) { return x + __int_as_float(__builtin_amdgcn_update_dpp(0, __float_as_int(x), CTRL, 0xf, 0xf, true)); }
__device__ __forceinline__ NOPK float red4(float x) { x = dpp_add<0xB1>(x); x = dpp_add<0x4E>(x); return x; }
__device__ __forceinline__ NOPK float red8(float x) { x = red4(x); return dpp_add<0x141>(x); }
__device__ __forceinline__ NOPK float red16(float x) { x = red8(x); return dpp_add<0x140>(x); }
__device__ __forceinline__ NOPK float fsigmoid(float x) { return __builtin_amdgcn_rcpf(1.0f + __builtin_amdgcn_exp2f(-1.44269504f * x)); }
__device__ __forceinline__ NOPK float ftanh(float x) { const float t = __builtin_amdgcn_exp2f(-2.88539008f * fabsf(x)); const float r = (1.0f - t) * __builtin_amdgcn_rcpf(1.0f + t); return x < 0.f ? -r : r; }
__device__ __forceinline__ NOPK float fsoftplus(float x) { return fmaxf(x, 0.f) + 0.69314718f * __builtin_amdgcn_logf(1.0f + __builtin_amdgcn_exp2f(-1.44269504f * fabsf(x))); }
__device__ __forceinline__ NOPK unsigned pk_fp8x4(float a, float b, float c, float d) { int w = 0; w = __builtin_amdgcn_cvt_pk_fp8_f32(a, b, w, false); w = __builtin_amdgcn_cvt_pk_fp8_f32(c, d, w, true); return (unsigned)w; }
constexpr float W8_SCALE = 64.0f; constexpr int W8_EXP = 127 - 3, A8_EXP = 127 - 3;
constexpr float Y8_SCALE = 16.0f;
#define LDS_WAIT() asm volatile("s_waitcnt lgkmcnt(0)" ::: "memory")
#define LDS_IADD(p, v) ((void)__hip_atomic_fetch_add((p), (v), __ATOMIC_RELAXED, __HIP_MEMORY_SCOPE_WORKGROUP))
#define LDS_BARRIER() do { asm volatile("s_waitcnt lgkmcnt(0)" ::: "memory"); __builtin_amdgcn_s_barrier(); asm volatile("" ::: "memory"); } while (0)
#define VM_WAIT() asm volatile("s_waitcnt vmcnt(0)" ::: "memory")

#define XB_TMO      128
#define XB_XCNT(j)  (256  + 64 * (j))
#define XB_XSUB(j)  (1280 + 64 * (j))
#define XB_XGEN(j)  (2304 + 64 * (j))
#define XB_TOP      3328
#define XB_TOPGEN   3392
#define XCD_BAR_WORDS 3456
#define XB_SPIN_CAP (1u << 18)
__device__ __forceinline__ NOPK unsigned xb_ld(unsigned* p)              { return __hip_atomic_load(p, __ATOMIC_RELAXED, __HIP_MEMORY_SCOPE_AGENT); }
__device__ __forceinline__ NOPK unsigned xb_add(unsigned* p, unsigned v) { return __hip_atomic_fetch_add(p, v, __ATOMIC_RELAXED, __HIP_MEMORY_SCOPE_AGENT); }
__device__ __forceinline__ NOPK unsigned xb_xcc_id() { return (unsigned)__builtin_amdgcn_s_getreg((3 << 11) | 20) & 0xFu; }
#define XB_SPIN(cond, bar) do { unsigned _sp = 0; while (cond) { __builtin_amdgcn_s_sleep(1); \
    if ((++_sp & 255u) == 0u) { if (xb_ld(&(bar)[XB_TMO])) break; if (_sp > XB_SPIN_CAP) { atomicAdd(&(bar)[XB_TMO], 1u); break; } } } } while (0)
struct XcdBarrier { unsigned* bar; unsigned x; volatile LAS unsigned* st; };
__device__ __forceinline__ NOPK XcdBarrier xcd_barrier_post(unsigned* bar, volatile LAS unsigned* st, int tid) {
    XcdBarrier b; b.bar = bar; b.x = xb_xcc_id(); b.st = st;
    if (tid == 0) (void)xb_add(&bar[XB_XCNT(b.x)], 1u);
    return b;
}
__device__ __forceinline__ NOPK void xcd_barrier_complete(unsigned* bar, unsigned x, unsigned& nloc, unsigned& nx) {
    const unsigned G = gridDim.x * gridDim.y * gridDim.z;
    unsigned sum, cnt, mine, sp = 0u;
    for (;;) {
        sum = 0u; cnt = 0u; mine = 0u;
#pragma unroll
        for (unsigned j = 0; j < 16; ++j) { const unsigned c = xb_ld(&bar[XB_XCNT(j)]); sum += c; cnt += (c > 0u) ? 1u : 0u; mine = (j == x) ? c : mine; }
        if (sum == G) break;
        __builtin_amdgcn_s_sleep(1);
        if ((++sp & 255u) == 0u) { if (xb_ld(&bar[XB_TMO])) break; if (sp > XB_SPIN_CAP) { atomicAdd(&bar[XB_TMO], 1u); break; } }
    }
    nloc = mine > 0u ? mine : 1u; nx = cnt > 0u ? cnt : 1u;
}
__device__ __forceinline__ NOPK void xcd_barrier(const XcdBarrier& b, int tid) {
    asm volatile("s_waitcnt vmcnt(0)" ::: "memory");
    __syncthreads();
    if (tid == 0) {
        unsigned* bar = b.bar;
        __builtin_amdgcn_s_waitcnt(0);
        unsigned nloc = b.st[0], nx = b.st[1];
        if (nloc == 0u) { xcd_barrier_complete(bar, b.x, nloc, nx); b.st[0] = nloc; b.st[1] = nx; }
        const unsigned old = xb_add(&bar[XB_XSUB(b.x)], 1u);
        const unsigned gen = old / nloc;
        if (old + 1u == (gen + 1u) * nloc) {
            __builtin_amdgcn_fence(__ATOMIC_RELEASE, "agent");
            asm volatile("s_waitcnt vmcnt(0)" ::: "memory");
            const unsigned og = xb_add(&bar[XB_TOP], 1u);
            const unsigned tg = og / nx;
            if (og + 1u == (tg + 1u) * nx) xb_add(&bar[XB_TOPGEN], 1u);
            else XB_SPIN(xb_ld(&bar[XB_TOPGEN]) == tg, bar);
            __builtin_amdgcn_fence(__ATOMIC_ACQUIRE, "agent");
            xb_add(&bar[XB_XGEN(b.x)], 1u);
            asm volatile("s_waitcnt vmcnt(0)" ::: "memory");
        } else {
            XB_SPIN(xb_ld(&bar[XB_XGEN(b.x)]) == gen, bar);
            __builtin_amdgcn_fence(__ATOMIC_ACQUIRE, "agent");
            asm volatile("s_waitcnt vmcnt(0)" ::: "memory");
        }
    }
    __syncthreads();
}

namespace pg8 {
constexpr int BM = 256, BK = 64, HALF = 128, HTB = HALF * BK * 2, STAGE_BYTES = 8 * HTB, NXCD = 8;
__host__ __device__ __forceinline__ NOPK int lds_byte(int r, int c) { const int st = (r >> 4) * 2 + (c >> 5), rr = r & 15, cc = c & 31, ob = rr * 64 + cc * 2; return st * 1024 + (ob ^ (((ob >> 9) & 1) << 5)); }
__host__ __device__ __forceinline__ NOPK void stage_rc(int b, int& R, int& C) { const int st = b / 1024, sb = b % 1024, swz = sb ^ (((sb >> 9) & 1) << 5); R = (st >> 1) * 16 + swz / 64; C = (st & 1) * 32 + (swz % 64) / 2; }
__host__ __device__ __forceinline__ NOPK int perm32(int rho) { const int n = rho >> 4, i = rho & 15; return 8 * (i >> 2) + 4 * n + (i & 3); }
__host__ __device__ __forceinline__ int perm64(int R) { const int wc = (R >> 5) & 3, rho = R & 31, n = rho >> 4, fq = (rho & 15) >> 2, e = rho & 3; return 64 * wc + 8 * fq + 4 * n + e; }
__host__ __device__ __forceinline__ int perm256(int R) { const int wc = (R >> 5) & 3, rho = R & 31, n = rho >> 4, fq = (rho & 15) >> 2, e = rho & 3; return 64 * wc + 16 * fq + 4 * n + e; }
struct Unit { int pm, pn, e; };
struct Gemm { const bf16* A; const bf16* Bt; int K; };

template <int WGM> struct StaticOrder {
    int nM, nN, nwg, G, c;
    __device__ __forceinline__ NOPK void init(int M_, int N_, int G_, int c_) { nM = M_ / BM; nN = N_ / BM; nwg = nM * nN; G = G_; c = c_; }
    __device__ __forceinline__ NOPK bool next(int i, Unit& u) const {
        const long L = (long)i * G + c; if (L >= nwg) return false;
        int wgid = (int)L; { const int q = nwg / NXCD, r = nwg % NXCD, xcd = wgid % NXCD, off = wgid / NXCD; wgid = (xcd < r ? xcd * (q + 1) : r * (q + 1) + (xcd - r) * q) + off; }
        const int nig = WGM * nN, gid = wgid / nig, fm = gid * WGM, gsz = (nM - fm) < WGM ? (nM - fm) : WGM;
        u.pm = fm + ((wgid % nig) % gsz); u.pn = (wgid % nig) / gsz; u.e = 0; return true;
    }
    __device__ __forceinline__ NOPK unsigned row_off(const Unit&, int) const { return 0u; }
};
template <int NPN, bool IDENT = false> struct MoeOrder {
    const LAS int* tab;
    const int* rowtok;
    int G, c, T, K2;
    __device__ __forceinline__ NOPK void init(const LAS int* tab_, const int* rowtok_, int G_, int c_, int K2_) { tab = tab_; rowtok = rowtok_; G = G_; c = c_; T = tab_[32]; K2 = K2_; }
    __device__ __forceinline__ NOPK bool next(int i, Unit& u) const {
        constexpr int TPR = 256 / NPN, TPX = TPR / 8;
        int tile, pnl;
        if (G == 256) { const int r = c >> 3; tile = i * TPR + (c & 7) * TPX + r / NPN; pnl = r % NPN; }
        else { const long L = (long)i * G + c; tile = (int)(L / NPN); pnl = (int)(L % NPN); }
        if (tile >= T) return false;
        const int lo = ((const LAS unsigned char*)tab)[1024 + tile];
        u.pm = tile; u.e = lo; u.pn = lo * NPN + pnl; return true;
    }
    __device__ __forceinline__ NOPK unsigned row_off(const Unit& u, int r) const {
        if constexpr (IDENT) return (unsigned)(u.pm * 256 + r) * (unsigned)K2;
        const int slot = (u.pm - tab[u.e]) * 256 + r; const int cnt = tab[64 + u.e];
        const int tok = slot < cnt ? rowtok[u.e * ECAP + slot] : 0;
        return (unsigned)tok * (unsigned)K2;
    }
};

template <class Epi, class Sched, bool GATHER, bool FP8 = false>
__device__ __forceinline__ NOPK void gemm_phase(LAS unsigned char* lds, const Gemm g, const Sched& S, const Epi& E, int tid_in) {
    int tid_ = tid_in; asm volatile("" : "+v"(tid_));
    const int tid = tid_, wid = __builtin_amdgcn_readfirstlane(tid >> 6), lane = tid & 63, wr = wid >> 2, wc = wid & 3, fr = lane & 15, fq = lane >> 4;
    int K_ = g.K; asm volatile("" : "+s"(K_));
    const int K = K_, nt = K / BK;
    unsigned voffA[2], voffB[2]; int RA[2];
#pragma unroll
    for (int i = 0; i < 2; ++i) { int R, C; stage_rc(tid * 16 + i * 8192, R, C); const int Rb = Epi::PERM == 2 ? perm256(R) : (Epi::PERM == 3 ? perm64(R) : (Epi::PERM ? ((R & ~31) + perm32(R & 31)) : R));
        RA[i] = R; voffA[i] = GATHER ? 0u : (unsigned)(R * K + C) * 2u; voffB[i] = (unsigned)(Rb * K + C) * 2u; }
    const unsigned kstep = (unsigned)(BK * 2);
    const unsigned hstep = (unsigned)HALF * (unsigned)K * 2u;
    const unsigned tstep = 2u * hstep;
    const unsigned hstepB = (Epi::PERM == 2) ? 8u * (unsigned)K * 2u : ((Epi::PERM == 3) ? 32u * (unsigned)K * 2u : hstep);
    const unsigned ldsw = (unsigned)wid * 1024u;
    const int aoff = lds_byte(wr * 64 + fr, fq * 8), boff = lds_byte(wc * 32 + fr, fq * 8);
    const __amdgpu_buffer_rsrc_t rA = __builtin_amdgcn_make_buffer_rsrc((void*)g.A, (short)0, (int)0xffffffffu, 0x00020000);
    const __amdgpu_buffer_rsrc_t rB = __builtin_amdgcn_make_buffer_rsrc((void*)g.Bt, (short)0, (int)0xffffffffu, 0x00020000);
#define PG8_SA(b, h) (((b) * 2 + (h)) * HTB)
#define PG8_SB(b, h) ((4 + (b) * 2 + (h)) * HTB)
#define PG8_STG(rs, bufoff, soff, voff) do { _Pragma("unroll") for (int _i = 0; _i < 2; ++_i) \
        __builtin_amdgcn_raw_ptr_buffer_load_lds(rs, (LAS unsigned*)(lds + (bufoff) + ldsw + _i * 8192), 16, (int)(voff)[_i], (int)(soff), 0, 0); } while (0)
#define PG8_STAGE_B(bufoff, soff) PG8_STG(rB, bufoff, soff, voffB)
#define PG8_STAGE_A(bufoff, h, kb) do { if constexpr (GATHER) { PG8_STG(rA, bufoff, kb, gA[h]); } else { PG8_STG(rA, bufoff, oA + (unsigned)(h) * hstep + (kb), voffA); } } while (0)
#define PG8_LDA(dst, b, h) do { _Pragma("unroll") for (int m = 0; m < 4; ++m) _Pragma("unroll") for (int k = 0; k < 2; ++k) dst[m][k] = *(const LAS bf16x8*)(lds + PG8_SA(b, h) + aoff + m * 2048 + k * 1024); } while (0)
#define PG8_LDB(dst, b, h) do { _Pragma("unroll") for (int n = 0; n < 2; ++n) _Pragma("unroll") for (int k = 0; k < 2; ++k) dst[n][k] = *(const LAS bf16x8*)(lds + PG8_SB(b, h) + boff + n * 2048 + k * 1024); } while (0)
#define PG8_CAT(x, y) __builtin_shufflevector(__builtin_bit_cast(i32x4, x), __builtin_bit_cast(i32x4, y), 0, 1, 2, 3, 4, 5, 6, 7)
#define PG8_MMA(ai, bj, At, Bt) do { __builtin_amdgcn_s_setprio(1); _Pragma("unroll") for (int m = 0; m < 4; ++m) _Pragma("unroll") for (int n = 0; n < 2; ++n) { \
        if constexpr (FP8) acc[ai][bj][m][n] = __builtin_amdgcn_mfma_scale_f32_16x16x128_f8f6f4(PG8_CAT(Bt[n][0], Bt[n][1]), PG8_CAT(At[m][0], At[m][1]), acc[ai][bj][m][n], 0, 0, 0, (Epi::PERM == 2 ? W8_EXP + 2 : W8_EXP), 0, (Epi::PERM == 2 ? A8_EXP + 2 : A8_EXP)); \
        else { _Pragma("unroll") for (int k = 0; k < 2; ++k) acc[ai][bj][m][n] = __builtin_amdgcn_mfma_f32_16x16x32_bf16(Bt[n][k], At[m][k], acc[ai][bj][m][n], 0, 0, 0); } } __builtin_amdgcn_s_setprio(0); } while (0)
#define PG8_WAIT_V(n) asm volatile("s_waitcnt vmcnt(" #n ")" ::: "memory")
#define PG8_WAIT_V8E() do { if (firstk) { if constexpr (Epi::NS == 8) asm volatile("s_waitcnt vmcnt(16)" ::: "memory"); else if constexpr (Epi::NS == 16) asm volatile("s_waitcnt vmcnt(24)" ::: "memory"); \
        else asm volatile("s_waitcnt vmcnt(40)" ::: "memory"); } else asm volatile("s_waitcnt vmcnt(8)" ::: "memory"); } while (0)
#define PG8_WAIT_L(n) asm volatile("s_waitcnt lgkmcnt(" #n ")" ::: "memory")
#define PG8_BAR __builtin_amdgcn_s_barrier()
#define PG8_SCHED __builtin_amdgcn_sched_barrier(0)
    Unit cur, nxt; int ui = 0;
    if (!S.next(0, cur)) return;
    f32x4 acc[2][2][4][2];
    { float z_ = 0.f; asm volatile("" : "+v"(z_));
#pragma unroll
    for (int a = 0; a < 2; ++a)
#pragma unroll
        for (int b = 0; b < 2; ++b)
#pragma unroll
            for (int m = 0; m < 4; ++m)
#pragma unroll
                for (int n = 0; n < 2; ++n) acc[a][b][m][n] = (f32x4){z_, z_, z_, z_}; }
    bf16x8 At[4][2], B0[2][2], B1[2][2];
    unsigned oA = GATHER ? 0u : (unsigned)cur.pm * tstep, oB = (unsigned)cur.pn * tstep;
    unsigned gA[2][2];
    if constexpr (GATHER) {
#pragma unroll
        for (int h = 0; h < 2; ++h)
#pragma unroll
            for (int i = 0; i < 2; ++i) { int R_, C_; stage_rc(tid * 16 + i * 8192, R_, C_); gA[h][i] = S.row_off(cur, h * HALF + R_) + (unsigned)(C_ * 2); }
    } else { gA[0][0] = gA[0][1] = gA[1][0] = gA[1][1] = 0u; }
    PG8_STAGE_B(PG8_SB(0, 0), oB); PG8_STAGE_B(PG8_SB(0, 1), oB + hstepB); PG8_STAGE_A(PG8_SA(0, 0), 0, 0u); PG8_STAGE_A(PG8_SA(0, 1), 1, 0u);
    if (wr == 1) PG8_BAR;
    PG8_WAIT_V(2); PG8_BAR;
    PG8_STAGE_B(PG8_SB(1, 0), oB + kstep); PG8_STAGE_A(PG8_SA(1, 0), 0, kstep); PG8_STAGE_B(PG8_SB(1, 1), oB + hstepB + kstep);
    PG8_WAIT_V(6); PG8_BAR;
    for (;;) {
        const bool has_next = S.next(ui + 1, nxt);
        const unsigned noA = (has_next && !GATHER) ? (unsigned)nxt.pm * tstep : oA, noB = has_next ? (unsigned)nxt.pn * tstep : oB;
#pragma nounroll
        for (int t = 0; t < nt; t += 2) {
            const bool last = (t == nt - 2), firstk = (t == 0) && (ui > 0);
            const unsigned b2 = last ? noB : oB + (unsigned)(t + 2) * kstep, b3 = b2 + kstep;
            const unsigned k2 = last ? 0u : (unsigned)(t + 2) * kstep;
            unsigned nA_[2][2];
            if constexpr (GATHER) {
                if (t == 0 && has_next) {
                    int tq_ = (int)__builtin_amdgcn_mbcnt_hi(~0u, __builtin_amdgcn_mbcnt_lo(~0u, 0u)); asm volatile("" : "+v"(tq_)); tq_ += wid * 64;
                    u32x4 pk_;
#pragma unroll
                    for (int h = 0; h < 2; ++h)
#pragma unroll
                        for (int i = 0; i < 2; ++i) { int R_, C_; stage_rc(tq_ * 16 + i * 8192, R_, C_); pk_[h * 2 + i] = S.row_off(nxt, h * HALF + R_) + (unsigned)(C_ * 2); }
                    *(LAS u32x4*)(lds + GOFF_OFF + tq_ * 16) = pk_; }
                if (last && has_next) {
                    int tq_ = (int)__builtin_amdgcn_mbcnt_hi(~0u, __builtin_amdgcn_mbcnt_lo(~0u, 0u)); asm volatile("" : "+v"(tq_)); tq_ += wid * 64;
                    const u32x4 pk_ = *(const LAS u32x4*)(lds + GOFF_OFF + tq_ * 16);
                    nA_[0][0] = pk_.x; nA_[0][1] = pk_.y; nA_[1][0] = pk_.z; nA_[1][1] = pk_.w; } }
            PG8_LDB(B0, 0, 0); PG8_LDB(B1, 0, 1); PG8_SCHED; PG8_LDA(At, 0, 0); PG8_STAGE_A(PG8_SA(1, 1), 1, (unsigned)(t + 1) * kstep);
            if (last) { if constexpr (GATHER) { if (has_next) {
#pragma unroll
                for (int h = 0; h < 2; ++h)
#pragma unroll
                    for (int i = 0; i < 2; ++i) gA[h][i] = nA_[h][i]; } } else { oA = noA; } }
            PG8_WAIT_V8E(); PG8_WAIT_L(0); PG8_BAR; PG8_MMA(0, 0, At, B0); PG8_MMA(0, 1, At, B1); PG8_BAR; PG8_SCHED;
            PG8_LDA(At, 0, 1); PG8_STAGE_B(PG8_SB(0, 0), b2); PG8_STAGE_B(PG8_SB(0, 1), b2 + hstepB); PG8_STAGE_A(PG8_SA(0, 0), 0, k2);
            PG8_WAIT_V8E(); PG8_WAIT_L(0); PG8_BAR; PG8_MMA(1, 0, At, B0); PG8_MMA(1, 1, At, B1); PG8_BAR; PG8_SCHED;
            PG8_LDB(B0, 1, 0); PG8_LDB(B1, 1, 1); PG8_SCHED; PG8_LDA(At, 1, 0); PG8_STAGE_A(PG8_SA(0, 1), 1, k2);
            PG8_WAIT_V(8); PG8_WAIT_L(0); PG8_BAR; PG8_MMA(0, 0, At, B0); PG8_MMA(0, 1, At, B1); PG8_BAR; PG8_SCHED;
            PG8_LDA(At, 1, 1); PG8_STAGE_B(PG8_SB(1, 0), b3); PG8_STAGE_B(PG8_SB(1, 1), b3 + hstepB); PG8_STAGE_A(PG8_SA(1, 0), 0, k2 + kstep);
            PG8_WAIT_V(8); PG8_WAIT_L(0); PG8_BAR; PG8_MMA(1, 0, At, B0); PG8_MMA(1, 1, At, B1); PG8_BAR; PG8_SCHED;
        }
        if (wr == 0) PG8_BAR;
        { int ln_ = (int)__builtin_amdgcn_mbcnt_hi(~0u, __builtin_amdgcn_mbcnt_lo(~0u, 0u)); asm volatile("" : "+v"(ln_));
          E(acc, cur, wr, wc, ln_ & 15, ln_ >> 4); }
        if (!has_next) break;
        { float z_ = 0.f; asm volatile("" : "+v"(z_));
#pragma unroll
        for (int a = 0; a < 2; ++a)
#pragma unroll
            for (int b = 0; b < 2; ++b)
#pragma unroll
                for (int m = 0; m < 4; ++m)
#pragma unroll
                    for (int n = 0; n < 2; ++n) acc[a][b][m][n] = (f32x4){z_, z_, z_, z_}; }
        cur = nxt; oB = noB; ++ui;
        if (wr == 1) PG8_BAR;
    }
    PG8_WAIT_V(0);
    PG8_BAR;
#undef PG8_SA
#undef PG8_SB
#undef PG8_STG
#undef PG8_STAGE_B
#undef PG8_STAGE_A
#undef PG8_LDA
#undef PG8_LDB
#undef PG8_MMA
#undef PG8_CAT
#undef PG8_WAIT_V
#undef PG8_WAIT_V8E
#undef PG8_WAIT_L
#undef PG8_BAR
#undef PG8_SCHED
}

struct EpiBf16 {
    static constexpr int PERM = 3; static constexpr int NS = 16;
    bf16* O; int ldc;
    __device__ __forceinline__ NOPK void operator()(const f32x4 (&acc)[2][2][4][2], const Unit& u, int wr, int wc, int fr, int fq) const {
        const int row0 = u.pm * BM + wr * 64 + fr, col0 = u.pn * BM + wc * 64 + 8 * fq;
#pragma unroll
        for (int ai = 0; ai < 2; ++ai)
#pragma unroll
            for (int m = 0; m < 4; ++m) { bf16* rowp = O + (size_t)(row0 + ai * HALF + m * 16) * ldc + col0;
#pragma unroll
                for (int bj = 0; bj < 2; ++bj) { const f32x4 v0 = acc[ai][bj][m][0], v1 = acc[ai][bj][m][1];
                    u32x4 w; w.x = cvt_pk_bf16(v0[0], v0[1]); w.y = cvt_pk_bf16(v0[2], v0[3]); w.z = cvt_pk_bf16(v1[0], v1[1]); w.w = cvt_pk_bf16(v1[2], v1[3]);
                    *(u32x4*)(rowp + bj * 32) = w; } }
    }
};
struct EpiResid {
    static constexpr bool PERM = true; static constexpr int NS = 16;
    const float* base; bf16* out; const float* gate;
    __device__ __forceinline__ NOPK void operator()(const f32x4 (&acc)[2][2][4][2], const Unit& u, int wr, int wc, int fr, int fq) const {
        const int row0 = u.pm * BM + wr * 64 + fr, col0 = u.pn * BM + wc * 32 + 8 * fq; const int b = (u.pm * BM) / SEQ;
        f32x4 gv[2][2];
#pragma unroll
        for (int bj = 0; bj < 2; ++bj)
#pragma unroll
            for (int n = 0; n < 2; ++n) gv[bj][n] = *(const f32x4*)(gate + (size_t)b * 6144 + col0 + bj * HALF + 4 * n);
#pragma unroll
        for (int ai = 0; ai < 2; ++ai)
#pragma unroll
            for (int m = 0; m < 4; ++m) { const size_t off = (size_t)(row0 + ai * HALF + m * 16) * D + col0;
#pragma unroll
                for (int bj = 0; bj < 2; ++bj) { const f32x4 b0 = *(const f32x4*)(base + off + bj * HALF), b1 = *(const f32x4*)(base + off + bj * HALF + 4);
                    const f32x4 o0 = b0 + gv[bj][0] * acc[ai][bj][m][0], o1 = b1 + gv[bj][1] * acc[ai][bj][m][1];
                    u32x4 w; w.x = cvt_pk_bf16(o0[0], o0[1]); w.y = cvt_pk_bf16(o0[2], o0[3]); w.z = cvt_pk_bf16(o1[0], o1[1]); w.w = cvt_pk_bf16(o1[2], o1[3]);
                    *(u32x4*)(out + off + bj * HALF) = w; } }
    }
};
struct EpiSwiglu {
    static constexpr bool PERM = true; static constexpr int NS = 8;
    unsigned char* O; const float* b1;
    __device__ __forceinline__ NOPK void operator()(const f32x4 (&acc)[2][2][4][2], const Unit& u, int wr, int wc, int fr, int fq) const {
        const int pnl = u.pn - u.e * 8; const int row0 = u.pm * BM + wr * 64 + fr, cg = pnl * 128 + wc * 32 + 8 * fq;
        const float* bp = b1 + (size_t)u.e * 2048 + cg;
        const f32x4 bg0 = *(const f32x4*)(bp), bg1 = *(const f32x4*)(bp + 4), bl0 = *(const f32x4*)(bp + 1024), bl1 = *(const f32x4*)(bp + 1028);
#pragma unroll
        for (int ai = 0; ai < 2; ++ai)
#pragma unroll
            for (int m = 0; m < 4; ++m) { unsigned char* rowp = O + (size_t)(row0 + ai * HALF + m * 16) * FF + cg;
                f32x4 o[2];
#pragma unroll
                for (int n = 0; n < 2; ++n) { const f32x4 gl = acc[ai][0][m][n] + (n ? bg1 : bg0), li = acc[ai][1][m][n] + (n ? bl1 : bl0);
#pragma unroll
                    for (int j = 0; j < 4; ++j) { const float gq = fminf(gl[j], 7.0f), lq = __builtin_amdgcn_fmed3f(li[j], -7.0f, 7.0f);
                        o[n][j] = gq * __builtin_amdgcn_rcpf(1.0f + __builtin_amdgcn_exp2f(-2.4554669f * gq)) * (lq + 1.0f); } }
                u32x2 w; w.x = pk_fp8x4(o[0][0], o[0][1], o[0][2], o[0][3]); w.y = pk_fp8x4(o[1][0], o[1][1], o[1][2], o[1][3]);
                *(u32x2*)rowp = w; }
    }
};
struct EpiY {
    static constexpr int PERM = 2; static constexpr int NS = 8;
    unsigned char* O; const float* b2;
    __device__ __forceinline__ NOPK void operator()(const f32x4 (&acc)[2][2][4][2], const Unit& u, int wr, int wc, int fr, int fq) const {
        const int pnl = u.pn - u.e * 4; const int row0 = u.pm * BM + wr * 64 + fr, col0 = pnl * BM + wc * 64 + 16 * fq;
        f32x4 bv[2][2];
#pragma unroll
        for (int bj = 0; bj < 2; ++bj)
#pragma unroll
            for (int n = 0; n < 2; ++n) bv[bj][n] = *(const f32x4*)(b2 + (size_t)u.e * D + col0 + 8 * bj + 4 * n) * Y8_SCALE;
#define Y8C(x) __builtin_amdgcn_fmed3f((x), -448.f, 448.f)
#pragma unroll
        for (int ai = 0; ai < 2; ++ai)
#pragma unroll
            for (int m = 0; m < 4; ++m) { unsigned char* rowp = O + (size_t)(row0 + ai * HALF + m * 16) * D + col0;
                u32x4 w;
#pragma unroll
                for (int bj = 0; bj < 2; ++bj) { const f32x4 v0 = acc[ai][bj][m][0] + bv[bj][0], v1 = acc[ai][bj][m][1] + bv[bj][1];
                    w[2 * bj] = pk_fp8x4(Y8C(v0[0]), Y8C(v0[1]), Y8C(v0[2]), Y8C(v0[3])); w[2 * bj + 1] = pk_fp8x4(Y8C(v1[0]), Y8C(v1[1]), Y8C(v1[2]), Y8C(v1[3])); }
                *(u32x4*)rowp = w; }
#undef Y8C
    }
};
}

struct Frame {
    LAS unsigned char* lds;
    int tid, lane, wave, G, bid;
    float* out; unsigned char* ws;
};
struct Args { const float* in[N_IN]; float* out; unsigned char* ws; int ph_lo, ph_hi; };

__device__ __forceinline__ NOPK void build_tab(Frame& F, int l) {
    LAS int* tab = (LAS int*)(F.lds + TAB_OFF);
    const unsigned* cnt = (const unsigned*)(F.ws + WS_CTL) + CW_CNT + 64 * l;
    if (F.tid < 32) tab[64 + F.tid] = (int)__hip_atomic_load(cnt + F.tid, __ATOMIC_RELAXED, __HIP_MEMORY_SCOPE_AGENT);
    __syncthreads();
    if (F.tid == 0) { int s = 0; for (int e = 0; e < 32; ++e) { tab[e] = s; s += (tab[64 + e] + 255) >> 8; } tab[32] = s; }
    __syncthreads();
    { LAS unsigned char* texp = (LAS unsigned char*)(F.lds + TAB_OFF + 1024); const int T = tab[32];
      for (int i = F.tid; i < T; i += 512) { int lo = 0, hi = 31; while (lo < hi) { const int mid = (lo + hi + 1) >> 1; if (tab[mid] <= i) lo = mid; else hi = mid - 1; } texp[i] = (unsigned char)lo; } }
    __syncthreads();
}

__device__ __forceinline__ NOPK void transpose_item(const float* W, int ldn, int k0, int n0, bf16* WT, int Kd, int drow0, int kvalid, LAS float* scr, int lane) {
#pragma unroll
    for (int i = 0; i < 8; ++i) { const int kk = 8 * i + (lane >> 3), nq = 4 * (lane & 7);
        const f32x4 v = kk < kvalid ? *(const f32x4*)(W + (size_t)(k0 + kk) * ldn + n0 + nq) : (f32x4){0.f, 0.f, 0.f, 0.f};
        scr[kk * 33 + nq] = v.x; scr[kk * 33 + nq + 1] = v.y; scr[kk * 33 + nq + 2] = v.z; scr[kk * 33 + nq + 3] = v.w; }
    LDS_WAIT(); asm volatile("" ::: "memory");
    const int c = lane & 7;
    if (8 * c < kvalid) {
#pragma unroll
        for (int j = 0; j < 4; ++j) { const int n = (lane >> 3) + 8 * j; const LAS float* s = scr + (8 * c) * 33 + n;
            u32x4 o; o.x = cvt_pk_bf16(s[0 * 33], s[1 * 33]); o.y = cvt_pk_bf16(s[2 * 33], s[3 * 33]); o.z = cvt_pk_bf16(s[4 * 33], s[5 * 33]); o.w = cvt_pk_bf16(s[6 * 33], s[7 * 33]);
            *(u32x4*)(WT + (size_t)(drow0 + n) * Kd + k0 + 8 * c) = o; }
    }
    LDS_WAIT(); asm volatile("" ::: "memory");
}
__device__ __forceinline__ NOPK void transpose_item_fp8(const float* W, int ldn, int k0, int n0, unsigned char* WT, int Kd, int drow0, LAS float* scr, int lane) {
#pragma unroll
    for (int i = 0; i < 8; ++i) { const int kk = 8 * i + (lane >> 3), nq = 4 * (lane & 7);
        const f32x4 v = *(const f32x4*)(W + (size_t)(k0 + kk) * ldn + n0 + nq);
        scr[kk * 33 + nq] = v.x; scr[kk * 33 + nq + 1] = v.y; scr[kk * 33 + nq + 2] = v.z; scr[kk * 33 + nq + 3] = v.w; }
    LDS_WAIT(); asm volatile("" ::: "memory");
    const int pc = lane & 3;
#define Q8(i) fminf(fmaxf(sp[(i) * 33] * W8_SCALE, -448.f), 448.f)
#pragma unroll
    for (int s2 = 0; s2 < 2; ++s2) { const int n = 16 * s2 + (lane >> 2); const LAS float* sp = scr + (16 * pc) * 33 + n;
        u32x4 o; o.x = pk_fp8x4(Q8(0), Q8(1), Q8(2), Q8(3)); o.y = pk_fp8x4(Q8(4), Q8(5), Q8(6), Q8(7)); o.z = pk_fp8x4(Q8(8), Q8(9), Q8(10), Q8(11)); o.w = pk_fp8x4(Q8(12), Q8(13), Q8(14), Q8(15));
        *(u32x4*)(WT + (size_t)(drow0 + n) * Kd + k0 + 16 * pc) = o; }
#undef Q8
    LDS_WAIT(); asm volatile("" ::: "memory");
}
__device__ __forceinline__ NOPK void p0_prologue(Frame& F, const Args& A) {
    if (F.bid < 192) {
        LAS float* cond = (LAS float*)F.lds;
        for (int i = F.tid; i < 32 * 1024; i += 512) { const float v = A.in[I_C][i]; cond[i] = v / (1.0f + __expf(-v)); }
        __syncthreads();
        const int l = F.bid / 96, j0 = (F.bid % 96) * 64;
        const float* W = A.in[I_ADAW] + (size_t)l * D * 6144 + j0;
        const int cq = F.lane & 15, kr = F.lane >> 4, b0 = F.wave * 4;
        f32x4 acc[4];
#pragma unroll
        for (int i = 0; i < 4; ++i) acc[i] = (f32x4){0.f, 0.f, 0.f, 0.f};
#pragma unroll 8
        for (int kk = 0; kk < 256; ++kk) { const int k = 4 * kk + kr; const f32x4 w = *(const f32x4*)(W + (size_t)k * 6144 + 4 * cq);
#pragma unroll
            for (int i = 0; i < 4; ++i) acc[i] += w * cond[(b0 + i) * 1024 + k]; }
#pragma unroll
        for (int i = 0; i < 4; ++i)
#pragma unroll
            for (int j = 0; j < 4; ++j) { float v = acc[i][j]; v += __shfl_xor(v, 16); v += __shfl_xor(v, 32); acc[i][j] = v; }
        if (kr == 0) { const f32x4 bb = *(const f32x4*)(A.in[I_ADAB] + (size_t)l * 6144 + j0 + 4 * cq);
#pragma unroll
            for (int i = 0; i < 4; ++i) *(f32x4*)((float*)(F.ws + WS_MOD) + ((size_t)l * 32 + b0 + i) * 6144 + j0 + 4 * cq) = acc[i] + bb; }
        __syncthreads();
    }
    if (F.bid == F.G - 1) {
        for (int i = F.tid; i < 2 * D * NE; i += 512) { const int l = i >> 15, r = i & 32767, k = r >> 5, e = r & 31; const float w = A.in[I_RW][i];
            const unsigned hi = cvt_pk_bf16(w, 0.f) & 0xffffu; const float rem = w - __uint_as_float(hi << 16); const unsigned lo = cvt_pk_bf16(rem, 0.f) & 0xffffu;
            bf16* dst = (bf16*)(F.ws + WS_LORA + (size_t)l * LORA_STRIDE + LO_RWS); dst[e * D + k] = (bf16)hi; dst[NE * D + e * D + k] = (bf16)lo; }
    }
    LAS float* scr = (LAS float*)(F.lds + F.wave * 16384);
    const int gw = F.bid * 8 + F.wave, NGW = F.G * 8;
    constexpr int I_IN = 16 * 104, I_OUT = 16 * 32, I_E1 = 16 * 64, I_E2 = 16 * 32;
    constexpr int N_IN_ITEMS = 2 * I_IN, N_OUT_ITEMS = 2 * I_OUT, N_E1 = 64 * I_E1, N_E2 = 64 * I_E2, N_LORA = 2 * (16 + 16 + 32) + 8 + 16;
    constexpr int NITEMS = N_IN_ITEMS + N_OUT_ITEMS + N_E1 + N_E2 + N_LORA;
    for (int it = gw; it < NITEMS; it += NGW) {
        int r = it;
        if (r < N_E1) { const int m = r / I_E1, q = r % I_E1, kb = q / 64, nb = q % 64, n0 = 32 * nb, jj = n0 & 1023, hi = n0 >> 10;
            transpose_item_fp8(A.in[I_W1] + (size_t)m * D * 2048, 2048, 64 * kb, n0, F.ws + WS_W1 + (size_t)m * 2048 * D, D, (jj >> 7) * 256 + hi * 128 + (jj & 127), scr, F.lane); continue; } r -= N_E1;
        if (r < N_E2) { const int m = r / I_E2, q = r % I_E2, kb = q / 32, nb = q % 32;
            transpose_item_fp8(A.in[I_W2] + (size_t)m * FF * D, D, 64 * kb, 32 * nb, F.ws + WS_W2 + (size_t)m * D * FF, FF, 32 * nb, scr, F.lane); continue; } r -= N_E2;
        if (r < N_IN_ITEMS) { const int l = r / I_IN, q = r % I_IN, kb = q / 104, nb = q % 104;
            transpose_item(A.in[I_WIN] + (size_t)l * D * C_IN, C_IN, 64 * kb, 32 * nb, (bf16*)(F.ws + WS_WIN) + (size_t)l * C_IN * D, D, 32 * nb, 64, scr, F.lane); continue; } r -= N_IN_ITEMS;
        if (r < N_OUT_ITEMS) { const int l = r / I_OUT, q = r % I_OUT, kb = q / 32, nb = q % 32;
            transpose_item(A.in[I_WOUT] + (size_t)l * D * D, D, 64 * kb, 32 * nb, (bf16*)(F.ws + WS_WOUT) + (size_t)l * D * D, D, 32 * nb, 64, scr, F.lane); continue; } r -= N_OUT_ITEMS;
        if (r < 128) { const int l = r / 64, q = r % 64; unsigned char* lo = F.ws + WS_LORA + (size_t)l * LORA_STRIDE;
            if (q < 16) transpose_item(A.in[I_DUP] + (size_t)l * 64 * DR, DR, 0, 32 * q, (bf16*)(lo + LO_DUP), 64, 32 * q, 64, scr, F.lane);
            else if (q < 32) transpose_item(A.in[I_IUP] + (size_t)l * 64 * DR, DR, 0, 32 * (q - 16), (bf16*)(lo + LO_IUP), 64, 32 * (q - 16), 64, scr, F.lane);
            else { const int qq = q - 32, kb = qq / 16, nb = qq % 16; transpose_item(A.in[I_GUP] + (size_t)l * 128 * DR, DR, 64 * kb, 32 * nb, (bf16*)(lo + LO_GUP), 128, 32 * nb, 64, scr, F.lane); }
            continue; } r -= 128;
        { unsigned char* lo = F.ws + WS_LORA + (size_t)1 * LORA_STRIDE;
          if (r < 8) transpose_item(A.in[I_VRD], 32, 64 * r, 0, (bf16*)(lo + LO_VRD), DR, 0, 64, scr, F.lane);
          else transpose_item(A.in[I_VRU], DR, 0, 32 * (r - 8), (bf16*)(lo + LO_VRU), 32, 32 * (r - 8), 32, scr, F.lane); }
    }
}

template <int MODE> __device__ __forceinline__ NOPK void norm_phase(Frame& F, const Args& A, int l) {
    if (MODE != 0) build_tab(F, MODE == 1 ? 0 : 1);
    const LAS int* tab = (const LAS int*)(F.lds + TAB_OFF);
    const float* mod = (const float*)(F.ws + WS_MOD);
    const unsigned char* Y = F.ws + WS_Y;
    const unsigned* tokslot = (const unsigned*)(F.ws + WS_TOKSLOT); const float* tokgate = (const float*)(F.ws + WS_TOKGATE);
    bf16* H = (bf16*)(F.ws + WS_H);
    const int gw = F.bid * 8 + F.wave, NGW = F.G * 8, TPW = M / NGW;
    for (int t0 = gw * TPW; t0 < M; t0 += NGW * TPW) {
        const int b = t0 / SEQ;
        f32x4 g1[4], sc[4], sh[4], g2[4];
#pragma unroll
        for (int j = 0; j < 4; ++j) { const int col = 4 * (64 * j + F.lane);
            if (MODE != 2) { g1[j] = *(const f32x4*)(A.in[I_N1G] + (size_t)l * D + col); sh[j] = *(const f32x4*)(mod + ((size_t)l * 32 + b) * 6144 + col); sc[j] = *(const f32x4*)(mod + ((size_t)l * 32 + b) * 6144 + 1024 + col) + 1.0f; }
            if (MODE != 0) g2[j] = *(const f32x4*)(mod + ((size_t)(MODE == 1 ? 0 : 1) * 32 + b) * 6144 + 5120 + col); }
        for (int tok = t0; tok < t0 + TPW; ++tok) {
            f32x4 v[4];
#pragma unroll
            for (int j = 0; j < 4; ++j) {
                if (MODE == 0) v[j] = *(const f32x4*)(A.in[I_X] + (size_t)tok * D + 4 * (64 * j + F.lane));
                else { const u32x2 w = *(const u32x2*)((const bf16*)(F.ws + WS_X1) + (size_t)tok * D + 4 * (64 * j + F.lane)); v[j] = (f32x4){bflo(w.x), bfhi(w.x), bflo(w.y), bfhi(w.y)}; } }
            if (MODE != 0) {
                f32x4 a[4];
#pragma unroll
                for (int j = 0; j < 4; ++j) a[j] = (f32x4){0.f, 0.f, 0.f, 0.f};
#pragma unroll
                for (int k = 0; k < 4; ++k) { const unsigned ts = tokslot[tok * 4 + k]; const float gk = tokgate[tok * 4 + k] * (1.0f / Y8_SCALE);
                    const size_t row = (size_t)tab[ts >> 16] * 256 + (ts & 0xffffu); const unsigned char* yr = Y + row * D;
#pragma unroll
                    for (int j = 0; j < 4; ++j) { const int w = *(const int*)(yr + 4 * (64 * j + F.lane)); const f32x2 lo = __builtin_amdgcn_cvt_pk_f32_fp8(w, false), hi = __builtin_amdgcn_cvt_pk_f32_fp8(w, true);
                        a[j] += gk * (f32x4){lo.x, lo.y, hi.x, hi.y}; } }
#pragma unroll
                for (int j = 0; j < 4; ++j) { v[j] += g2[j] * a[j]; *(f32x4*)(F.out + (size_t)tok * D + 4 * (64 * j + F.lane)) = v[j]; }
            }
            if (MODE != 2) {
                float ss = 0.f;
#pragma unroll
                for (int j = 0; j < 4; ++j) ss += (v[j].x * v[j].x + v[j].y * v[j].y) + (v[j].z * v[j].z + v[j].w * v[j].w);
                const float rstd = 1.0f / sqrtf(wave_sum(ss) * (1.0f / D) + NORM_EPS);
#pragma unroll
                for (int j = 0; j < 4; ++j) { const f32x4 h = v[j] * rstd * g1[j] * sc[j] + sh[j]; u32x2 w; w.x = cvt_pk_bf16(h.x, h.y); w.y = cvt_pk_bf16(h.z, h.w);
                    *(u32x2*)(H + (size_t)tok * D + 4 * (64 * j + F.lane)) = w; }
            }
        }
    }
}

__device__ __forceinline__ NOPK u32x4 ldg16(const bf16* p) { return *(const u32x4*)p; }
__device__ __forceinline__ NOPK void unpack8(const u32x4 w, float (&f)[8]) { f[0] = bflo(w.x); f[1] = bfhi(w.x); f[2] = bflo(w.y); f[3] = bfhi(w.y); f[4] = bflo(w.z); f[5] = bfhi(w.z); f[6] = bflo(w.w); f[7] = bfhi(w.w); }
__device__ __forceinline__ NOPK void shifted8(const bf16* Z, size_t tokrow, bool has_prev, int col, const float* mu, float (&o)[8]) {
    float c[8], p[8]; unpack8(ldg16(Z + tokrow * C_IN + col), c);
    if (has_prev) unpack8(ldg16(Z + (tokrow - 1) * C_IN + col), p); else {
#pragma unroll
        for (int i = 0; i < 8; ++i) p[i] = 0.f; }
    const f32x4 m0 = *(const f32x4*)(mu + col), m1 = *(const f32x4*)(mu + col + 4);
#pragma unroll
    for (int i = 0; i < 8; ++i) o[i] = c[i] + (p[i] - c[i]) * (i < 4 ? m0[i] : m1[i - 4]);
}
__device__ __forceinline__ NOPK void ld8f(const float* p, float (&o)[8]) { const f32x4 a = *(const f32x4*)p, b = *(const f32x4*)(p + 4); o[0] = a.x; o[1] = a.y; o[2] = a.z; o[3] = a.w; o[4] = b.x; o[5] = b.y; o[6] = b.z; o[7] = b.w; }
__device__ __forceinline__ NOPK void lds8f(const LAS float* p, float (&o)[8]) { const f32x4 a = *(const LAS f32x4*)p, b = *(const LAS f32x4*)(p + 4); o[0] = a.x; o[1] = a.y; o[2] = a.z; o[3] = a.w; o[4] = b.x; o[5] = b.y; o[6] = b.z; o[7] = b.w; }
__device__ __forceinline__ NOPK bf16x8 pack8(const float (&f)[8]) { u32x4 w; w.x = cvt_pk_bf16(f[0], f[1]); w.y = cvt_pk_bf16(f[2], f[3]); w.z = cvt_pk_bf16(f[4], f[5]); w.w = cvt_pk_bf16(f[6], f[7]); return __builtin_bit_cast(bf16x8, w); }

__device__ __forceinline__ NOPK void n2r_phase(Frame& F, const Args& A, int l) {
    constexpr int XP = 1032, XBUF = 33 * 1024;
    LAS float* SS = (LAS float*)(F.lds + 2 * XBUF);
    LAS float* PL = SS + 128;
    LAS float* LG = PL + 8 * 512;
    LAS unsigned* ent = (LAS unsigned*)(LG + 512 + 128);
    LAS unsigned* lcnt = ent + 2048; LAS unsigned* lbase = lcnt + 32;
    LAS float* GG = (LAS float*)(lbase + 32); LAS float* SH = GG + 1024;
    static_assert(2 * XBUF + (128 + 4096 + 640) * 4 + 8192 + 256 + 8192 <= MISC_OFF, "n2r LDS map");
    if (F.tid < 32) lcnt[F.tid] = 0u;
    const float* mod = (const float*)(F.ws + WS_MOD);
    const bf16* X1 = (const bf16*)(F.ws + WS_X1);
    unsigned char* H8 = F.ws + WS_H;
    unsigned* gcnt = (unsigned*)(F.ws + WS_CTL) + CW_CNT + 64 * l;
    int* rowtok = (int*)(F.ws + WS_ROWTOK); unsigned* tokslot = (unsigned*)(F.ws + WS_TOKSLOT); float* tokgate = (float*)(F.ws + WS_TOKGATE);
    const int fr = F.lane & 15, kq = F.lane >> 4, w = F.wave;
    bf16x8 WB[4][2][2];
    { const bf16* src = (const bf16*)(F.ws + WS_LORA + (size_t)l * LORA_STRIDE + LO_RWS);
#pragma unroll
      for (int ks = 0; ks < 4; ++ks)
#pragma unroll
          for (int nb = 0; nb < 2; ++nb)
#pragma unroll
              for (int hl = 0; hl < 2; ++hl) WB[ks][nb][hl] = *(const bf16x8*)(src + (size_t)hl * NE * D + (size_t)(16 * nb + fr) * D + 128 * w + 32 * ks + 8 * kq); }
    const float rb = A.in[I_RB][l * NE + (F.lane & 31)];
#define N2_DMA(TILE, BUF) do { _Pragma("unroll") for (int k_ = 0; k_ < 5; ++k_) { const int i_ = w + 8 * k_; if (i_ < 33) { const int P_ = i_ * 64 + F.lane; int row_ = P_ / 129; const int pc_ = P_ - row_ * 129; \
            const bool ok_ = row_ < 16 && pc_ < 128; row_ = row_ < 16 ? row_ : 15; \
            __builtin_amdgcn_global_load_lds((const unsigned*)(X1 + (size_t)(blk * 256 + (TILE) * 16 + row_) * D + (ok_ ? pc_ * 8 : 0)), (LAS unsigned*)(F.lds + (BUF) * XBUF + i_ * 1024), 16, 0, 0); } } } while (0)
    for (int blk = F.bid; blk < M / 256; blk += F.G) {
        const int b = (blk * 256) / SEQ;
        const float* g2p = A.in[I_N2G] + (size_t)l * D; const float* shp = mod + ((size_t)l * 32 + b) * 6144 + 3072; const float* scp = shp + 1024;
        N2_DMA(0, 0);
        for (int i = F.tid; i < D; i += 512) { GG[i] = g2p[i] * (1.0f + scp[i]); SH[i] = shp[i]; }
#pragma unroll 1
        for (int tile = 0; tile < 16; ++tile) {
            if (tile + 1 < 16) { N2_DMA(tile + 1, (tile + 1) & 1); if (w == 0) asm volatile("s_waitcnt vmcnt(5)" ::: "memory"); else asm volatile("s_waitcnt vmcnt(4)" ::: "memory"); }
            else asm volatile("s_waitcnt vmcnt(0)" ::: "memory");
            LDS_BARRIER();
            const LAS bf16* xt = (const LAS bf16*)(F.lds + (tile & 1) * XBUF) + fr * XP + 128 * w + 8 * kq;
            float x[4][8]; float ss = 0.f;
#pragma unroll
            for (int ks = 0; ks < 4; ++ks) { unpack8(*(const LAS u32x4*)(xt + 32 * ks), x[ks]);
#pragma unroll
                for (int i = 0; i < 8; ++i) ss += x[ks][i] * x[ks][i]; }
            ss += __shfl_xor(ss, 16); ss += __shfl_xor(ss, 32);
            if (kq == 0) SS[w * 16 + fr] = ss;
            LDS_BARRIER();
            float tot = 0.f;
#pragma unroll
            for (int ww = 0; ww < 8; ++ww) tot += SS[ww * 16 + fr];
            const float rstd = 1.0f / sqrtf(tot * (1.0f / D) + NORM_EPS);
            const int tok = blk * 256 + tile * 16 + fr;
            f32x4 acc0 = (f32x4){0.f, 0.f, 0.f, 0.f}, acc1 = acc0;
#pragma unroll
            for (int ks = 0; ks < 4; ++ks) { const int col = 128 * w + 32 * ks + 8 * kq;
                float g[8], sh[8], lo[8]; lds8f(GG + col, g); lds8f(SH + col, sh);
#pragma unroll
                for (int i = 0; i < 8; ++i) x[ks][i] = x[ks][i] * rstd * g[i] + sh[i];
                const bf16x8 hi8 = pack8(x[ks]); const u32x4 hw = __builtin_bit_cast(u32x4, hi8);
                { u32x2 q8; q8.x = pk_fp8x4(__builtin_amdgcn_fmed3f(x[ks][0], -448.f, 448.f), __builtin_amdgcn_fmed3f(x[ks][1], -448.f, 448.f), __builtin_amdgcn_fmed3f(x[ks][2], -448.f, 448.f), __builtin_amdgcn_fmed3f(x[ks][3], -448.f, 448.f));
                  q8.y = pk_fp8x4(__builtin_amdgcn_fmed3f(x[ks][4], -448.f, 448.f), __builtin_amdgcn_fmed3f(x[ks][5], -448.f, 448.f), __builtin_amdgcn_fmed3f(x[ks][6], -448.f, 448.f), __builtin_amdgcn_fmed3f(x[ks][7], -448.f, 448.f));
                  *(u32x2*)(H8 + (size_t)tok * D + col) = q8; }
                lo[0] = x[ks][0] - bflo(hw.x); lo[1] = x[ks][1] - bfhi(hw.x); lo[2] = x[ks][2] - bflo(hw.y); lo[3] = x[ks][3] - bfhi(hw.y); lo[4] = x[ks][4] - bflo(hw.z); lo[5] = x[ks][5] - bfhi(hw.z); lo[6] = x[ks][6] - bflo(hw.w); lo[7] = x[ks][7] - bfhi(hw.w);
                const bf16x8 lo8 = pack8(lo);
                acc0 = __builtin_amdgcn_mfma_f32_16x16x32_bf16(hi8, WB[ks][0][0], acc0, 0, 0, 0); acc1 = __builtin_amdgcn_mfma_f32_16x16x32_bf16(hi8, WB[ks][1][0], acc1, 0, 0, 0);
                acc0 = __builtin_amdgcn_mfma_f32_16x16x32_bf16(lo8, WB[ks][0][0], acc0, 0, 0, 0); acc1 = __builtin_amdgcn_mfma_f32_16x16x32_bf16(lo8, WB[ks][1][0], acc1, 0, 0, 0);
                acc0 = __builtin_amdgcn_mfma_f32_16x16x32_bf16(hi8, WB[ks][0][1], acc0, 0, 0, 0); acc1 = __builtin_amdgcn_mfma_f32_16x16x32_bf16(hi8, WB[ks][1][1], acc1, 0, 0, 0); }
#pragma unroll
            for (int j = 0; j < 4; ++j) { PL[w * 512 + (4 * kq + j) * 32 + fr] = acc0[j]; PL[w * 512 + (4 * kq + j) * 32 + 16 + fr] = acc1[j]; }
            LDS_BARRIER();
            {
                const int tt = 2 * w + (F.lane >> 5), e = F.lane & 31;
                float logit = rb;
#pragma unroll
                for (int ww = 0; ww < 8; ++ww) logit += PL[ww * 512 + tt * 32 + e];
                LG[tt * 32 + e] = logit;
                LDS_WAIT(); asm volatile("" ::: "memory");
                int rank = 0;
#pragma unroll
                for (int q = 0; q < 8; ++q) { const f32x4 o = *(const LAS f32x4*)(LG + tt * 32 + 4 * q);
#pragma unroll
                    for (int j = 0; j < 4; ++j) { const int e2 = 4 * q + j; rank += (o[j] > logit || (o[j] == logit && e2 < e)) ? 1 : 0; } }
                if (rank < 4) { LG[512 + tt * 8 + rank] = __int_as_float(e); LG[512 + tt * 8 + 4 + rank] = logit; }
                LDS_WAIT(); asm volatile("" ::: "memory");
                if (e < 4) {
                    const f32x4 sv = *(const LAS f32x4*)(LG + 512 + tt * 8 + 4);
                    const float inv = 1.0f / (((1.0f + __expf(sv.y - sv.x)) + __expf(sv.z - sv.x)) + __expf(sv.w - sv.x));
                    const int ek = __float_as_int(LG[512 + tt * 8 + e]); const float gk = __expf(LG[512 + tt * 8 + 4 + e] - sv.x) * inv;
                    const unsigned rk = __hip_atomic_fetch_add(lcnt + ek, 1u, __ATOMIC_RELAXED, __HIP_MEMORY_SCOPE_WORKGROUP);
                    ent[((tile * 16 + tt) * 4 + e) * 2] = ((unsigned)ek << 16) | rk; ent[((tile * 16 + tt) * 4 + e) * 2 + 1] = __float_as_uint(gk); }
            }
        }
        __syncthreads();
        if (F.tid < 32) lbase[F.tid] = atomicAdd(gcnt + F.tid, lcnt[F.tid]);
        __syncthreads();
        for (int idx = F.tid; idx < 1024; idx += 512) { const unsigned wv = ent[idx * 2]; const int ek = wv >> 16; const unsigned slot = lbase[ek] + (wv & 0xffffu); const int tok = blk * 256 + (idx >> 2);
            rowtok[ek * ECAP + slot] = tok; tokslot[tok * 4 + (idx & 3)] = ((unsigned)ek << 16) | slot; tokgate[tok * 4 + (idx & 3)] = __uint_as_float(ent[idx * 2 + 1]); }
        __syncthreads();
        if (F.tid < 32) lcnt[F.tid] = 0u;
        __syncthreads();
    }
#undef N2_DMA
}

__device__ __forceinline__ NOPK void prep_phase(Frame& F, const Args& A, int l) {
    const bf16* Z = (const bf16*)(F.ws + WS_Z);
    const unsigned char* lo = F.ws + WS_LORA + (size_t)l * LORA_STRIDE;
    const bf16* dupT = (const bf16*)(lo + LO_DUP); const bf16* iupT = (const bf16*)(lo + LO_IUP); const bf16* gupT = (const bf16*)(lo + LO_GUP);
    const bf16* vrdT = (const bf16*)(lo + LO_VRD); const bf16* vruT = (const bf16*)(lo + LO_VRU);
    bf16* OPS = (bf16*)(F.ws + WS_OPS); bf16* QN = (bf16*)(F.ws + WS_QN); bf16* KN = (bf16*)(F.ws + WS_KN); bf16* VF = (bf16*)(F.ws + WS_VF); bf16* VFIRST = (bf16*)(F.ws + WS_VFIRST); float* BON = (float*)(F.ws + WS_BON);
    constexpr int ZROW = 1544, ZBUF = 53248, AFROW = 264, AF_OFF = 2 * ZBUF, SW_OFF = AF_OFF + 16 * AFROW * 2, MA_OFF = SW_OFF + 8 * 2048, PT_OFF = MA_OFF + 4096;
    constexpr int PT_MU = 0, PT_DW0 = 1792, PT_IA0 = 2304, PT_KK = 2816, PT_KA = 3328, PT_VRB = 3840, PT_QG = 4352, PT_KG = 4416, PT_RK = 4480, PT_N = 4992;
    static_assert(PT_OFF + PT_N * 4 <= MISC_OFF, "prep LDS map");
    LAS bf16* AF = (LAS bf16*)(F.lds + AF_OFF);
    LAS bf16* sW = (LAS bf16*)(F.lds + SW_OFF + F.wave * 2048);
    LAS float* PT = (LAS float*)(F.lds + PT_OFF);
    const int h = F.wave, lane0 = F.lane;
    for (int i = F.tid; i < PT_N; i += 512) {
        float v;
        if (i < PT_DW0) v = A.in[I_MU][(size_t)l * C_RWKV + i];
        else if (i < PT_IA0) v = A.in[I_DW0][l * DR + i - PT_DW0];
        else if (i < PT_KK) v = A.in[I_IA0][l * DR + i - PT_IA0];
        else if (i < PT_KA) v = A.in[I_KK][l * DR + i - PT_KK];
        else if (i < PT_VRB) v = A.in[I_KA][l * DR + i - PT_KA];
        else if (i < PT_QG) v = A.in[I_VRB][i - PT_VRB];
        else if (i < PT_KG) v = A.in[I_QG][l * HD + i - PT_QG];
        else if (i < PT_RK) v = A.in[I_KG][l * HD + i - PT_KG];
        else v = A.in[I_RK][l * DR + i - PT_RK];
        PT[i] = v;
    }
    { LAS float* m = (LAS float*)(F.lds + MA_OFF); m[F.tid] = 0.f; m[512 + F.tid] = 0.f; }
#define PREP_DMA(uu, buf) do { const int tk0_ = (uu) * 16; _Pragma("unroll") for (int k_ = 0; k_ < 7; ++k_) { const int i_ = F.wave + 8 * k_; if (i_ < 52) { int ln_ = lane; asm volatile("" : "+v"(ln_)); const int P_ = i_ * 64 + ln_; int row_ = P_ / 193; const int pc_ = P_ - row_ * 193; \
        const bool ok_ = row_ < 17; row_ = ok_ ? row_ : 16; const int spc_ = (ok_ && pc_ < 192) ? pc_ : 0; int tg_ = tk0_ - 1 + row_; tg_ = tg_ < 0 ? 0 : tg_; \
        __builtin_amdgcn_global_load_lds((const unsigned*)(Z + (size_t)tg_ * C_IN + spc_ * 8), (LAS unsigned*)(F.lds + (buf) * ZBUF + i_ * 1024), 16, 0, 0); } } } while (0)
#define PREP_LDR(uu) do { const size_t tk_ = (size_t)(uu) * 16 + tau; aq0 = ldg16(Z + tk_ * C_IN + 1792 + hc); aq1 = ldg16(Z + tk_ * C_IN + 1792 + hc + 32); ak0 = ldg16(Z + tk_ * C_IN + 2304 + hc); ak1 = ldg16(Z + tk_ * C_IN + 2304 + hc + 32); \
        av0 = ldg16(Z + tk_ * C_IN + 2816 + hc); av1 = ldg16(Z + tk_ * C_IN + 2816 + hc + 32); \
        const size_t tf_ = (size_t)(uu) * 16 + fr; lcC = ldg16(Z + tf_ * C_IN + 1536 + 32 * h + 8 * kq); lcP = ldg16(Z + (tf_ > 0 ? tf_ - 1 : 0) * C_IN + 1536 + 32 * h + 8 * kq); } while (0)
#define ZSH8(rr, hasp, col, OUT) do { float c_[8], p_[8], m_[8]; unpack8(*(const LAS u32x4*)(ZS + ((rr) + 1) * ZROW + (col)), c_); unpack8(*(const LAS u32x4*)(ZS + (rr) * ZROW + (col)), p_); lds8f(PT + PT_MU + (col), m_); \
            _Pragma("unroll") for (int i_ = 0; i_ < 8; ++i_) { const float pp_ = (hasp) ? p_[i_] : 0.f; OUT[i_] = c_[i_] + (pp_ - c_[i_]) * m_[i_]; } } while (0)
#define ZSH16(rr, hasp, col, OUT) do { ZSH8(rr, hasp, col, (*(float(*)[8])&OUT[0])); ZSH8(rr, hasp, (col) + 32, (*(float(*)[8])&OUT[8])); } while (0)
#define PREP_LDB(BF, WT, KD, NKS) do { int fo_ = (64 * h + fr) * (KD) + 8 * kq; asm volatile("" : "+v"(fo_));     \
        _Pragma("unroll") for (int nb_ = 0; nb_ < 4; ++nb_) _Pragma("unroll") for (int ks_ = 0; ks_ < (NKS); ++ks_) BF[nb_][ks_] = *(const bf16x8*)((WT) + fo_ + 16 * nb_ * (KD) + 32 * ks_); } while (0)
#define PREP_LORA(BF, ACOL, NKS) do { bf16x8 Af_[NKS]; _Pragma("unroll") for (int ks_ = 0; ks_ < (NKS); ++ks_) Af_[ks_] = *(const LAS bf16x8*)(AF + fr * AFROW + (ACOL) + 32 * ks_ + 8 * kq); \
        _Pragma("unroll") for (int nb_ = 0; nb_ < 4; ++nb_) { f32x4 acc_ = (f32x4){0.f, 0.f, 0.f, 0.f}; \
            _Pragma("unroll") for (int ks_ = 0; ks_ < (NKS); ++ks_) acc_ = __builtin_amdgcn_mfma_f32_16x16x32_bf16(Af_[ks_], BF[nb_][ks_], acc_, 0, 0, 0); \
            _Pragma("unroll") for (int j_ = 0; j_ < 4; ++j_) sW[(4 * kq + j_) * 64 + 16 * nb_ + fr] = (bf16)(cvt_pk_bf16(acc_[j_], 0.f) & 0xffffu); } \
        LDS_WAIT(); asm volatile("" ::: "memory"); } while (0)
#define SW16(OUT) do { unpack8(*(const LAS u32x4*)(sW + tau * 64 + 8 * q), (*(float(*)[8])&OUT[0])); unpack8(*(const LAS u32x4*)(sW + tau * 64 + 8 * q + 32), (*(float(*)[8])&OUT[8])); } while (0)
#define PT16(OFF, OUT) do { lds8f(PT + (OFF), (*(float(*)[8])&OUT[0])); lds8f(PT + (OFF) + 32, (*(float(*)[8])&OUT[8])); } while (0)
#define ST16(DST, V) do { *(u32x4*)(DST) = __builtin_bit_cast(u32x4, pack8(*(const float(*)[8])&V[0])); *(u32x4*)((DST) + 32) = __builtin_bit_cast(u32x4, pack8(*(const float(*)[8])&V[8])); } while (0)
#define ST16O(DST, V) do { *(u32x4*)(DST) = __builtin_bit_cast(u32x4, pack8(*(const float(*)[8])&V[0])); *(u32x4*)((DST) + 512) = __builtin_bit_cast(u32x4, pack8(*(const float(*)[8])&V[8])); } while (0)
    constexpr int NU = M / 16;
    u32x4 aq0, aq1, ak0, ak1, av0, av1, lcC, lcP;
    int u = F.bid, par = 0;
    if (u < NU) { const int lane = lane0, fr = lane & 15, kq = lane >> 4, tau = lane >> 2, q = lane & 3, hc = 64 * h + 8 * q; PREP_DMA(u, 0); PREP_LDR(u); }
    bool first = true;
    for (; u < NU; u += F.G, par ^= 1) {
        int lane = lane0; asm volatile("" : "+v"(lane));
        const int fr = lane & 15, kq = lane >> 4, tau = lane >> 2, q = lane & 3, hc = 64 * h + 8 * q;
        const int b = u >> 7, t0 = (u & 127) * 16, tok0 = u * 16, un = u + F.G;
        const size_t tok = (size_t)tok0 + tau; const int tpos = t0 + tau; const bool hp = tpos > 0;
        if (first) asm volatile("s_waitcnt vmcnt(0)" ::: "memory"); else asm volatile("s_waitcnt vmcnt(6)" ::: "memory");
        first = false;
        LDS_BARRIER();
        bf16x8 Bw[4][2], Ba[4][2], Bg[4][4], Bv[4][1];
        PREP_LDB(Bw, dupT, 64, 2);
        if (un < NU) PREP_DMA(un, par ^ 1);
        const LAS bf16* ZS = (const LAS bf16*)(F.lds + par * ZBUF);
        LAS float* MAc = (LAS float*)(F.lds + MA_OFF + par * 2048);
        { float x[16]; unpack8(aq0, *(float(*)[8])&x[0]); unpack8(aq1, *(float(*)[8])&x[8]);
          float s = 0.f;
#pragma unroll
          for (int i = 0; i < 16; ++i) s += x[i] * x[i];
          s = red4(s); const float r = 0.125f / sqrtf(s * (1.0f / 64.0f) + NORM_EPS);
          float gq[16]; PT16(PT_QG + 8 * q, gq);
#pragma unroll
          for (int i = 0; i < 16; ++i) x[i] = x[i] * r * gq[i];
          bf16* o = QN + (((size_t)b * NH + h) * SEQ + tpos) * 64 + 8 * q; ST16(o, x); }
        { float x[16]; unpack8(ak0, *(float(*)[8])&x[0]); unpack8(ak1, *(float(*)[8])&x[8]);
          float s = 0.f;
#pragma unroll
          for (int i = 0; i < 16; ++i) s += x[i] * x[i];
          s = red4(s); const float r = 1.0f / sqrtf(s * (1.0f / 64.0f) + NORM_EPS);
          float gk[16]; PT16(PT_KG + 8 * q, gk);
#pragma unroll
          for (int i = 0; i < 16; ++i) x[i] = x[i] * r * gk[i];
          bf16* o = KN + (((size_t)b * NH + h) * SEQ + tpos) * 64 + 8 * q; ST16(o, x); }
        { const unsigned vw[8] = {av0.x, av0.y, av0.z, av0.w, av1.x, av1.y, av1.z, av1.w};
          const int hh = (tau >> 2) & 1, jj = 4 * (tau >> 3) + (tau & 3);
          LAS bf16* sT = sW;
#pragma unroll
          for (int i = 0; i < 16; ++i) { const int d = 8 * q + (i & 7) + 32 * (i >> 3); sT[(hh * 64 + d) * 8 + jj] = (bf16)((i & 1) ? (vw[i >> 1] >> 16) : (vw[i >> 1] & 0xffffu)); }
          LDS_WAIT(); asm volatile("" ::: "memory");
          const u32x4 o0 = *(const LAS u32x4*)(sT + 8 * lane), o1 = *(const LAS u32x4*)(sT + 512 + 8 * lane);
          bf16* o = VF + ((((size_t)b * NH + h) * 128 + (tpos >> 4)) * 1024) + 8 * lane;
          *(u32x4*)o = o0; *(u32x4*)(o + 512) = o1;
          LDS_WAIT(); asm volatile("" ::: "memory"); }
        { float c_[8], p_[8], m_[8], x[8]; unpack8(lcC, c_); unpack8(lcP, p_); lds8f(PT + PT_MU + 1536 + 32 * h + 8 * kq, m_); const bool hpf = (t0 + fr) > 0;
#pragma unroll
          for (int i = 0; i < 8; ++i) { const float pp = hpf ? p_[i] : 0.f; x[i] = c_[i] + (pp - c_[i]) * m_[i]; x[i] = h < 2 ? ftanh(x[i]) : (h < 4 ? x[i] : fsigmoid(x[i])); }
          *(LAS u32x4*)(AF + fr * AFROW + 32 * h + 8 * kq) = __builtin_bit_cast(u32x4, pack8(x)); }
        if (l == 1) {
            f32x4 m0 = (f32x4){0.f, 0.f, 0.f, 0.f}, m1 = m0;
#pragma unroll
            for (int k2 = 0; k2 < 2; ++k2) { const int ks = 2 * h + k2; float x[8]; ZSH8(fr, (t0 + fr) > 0, 1024 + 32 * ks + 8 * kq, x); const bf16x8 a = pack8(x);
                m0 = __builtin_amdgcn_mfma_f32_16x16x32_bf16(a, *(const bf16x8*)(vrdT + (size_t)fr * DR + 32 * ks + 8 * kq), m0, 0, 0, 0);
                m1 = __builtin_amdgcn_mfma_f32_16x16x32_bf16(a, *(const bf16x8*)(vrdT + (size_t)(16 + fr) * DR + 32 * ks + 8 * kq), m1, 0, 0, 0); }
#pragma unroll
            for (int j = 0; j < 4; ++j) {
                LDS_IADD((LAS int*)MAc + (4 * kq + j) * 32 + fr, (int)__builtin_rintf(__builtin_amdgcn_fmed3f(m0[j], -8000.f, 8000.f) * 262144.f));
                LDS_IADD((LAS int*)MAc + (4 * kq + j) * 32 + 16 + fr, (int)__builtin_rintf(__builtin_amdgcn_fmed3f(m1[j], -8000.f, 8000.f) * 262144.f)); }
        }
        if (un < NU) PREP_LDR(un);
        PREP_LDB(Ba, iupT, 64, 2);
        LDS_BARRIER();
        u32x4 vf0, vf1;
        if (l == 1) { vf0 = ldg16(VFIRST + tok * DR + hc); vf1 = ldg16(VFIRST + tok * DR + hc + 32);
            if (F.wave == 0) { LAS f32x4* z = (LAS f32x4*)(F.lds + MA_OFF + (par ^ 1) * 2048); z[lane] = (f32x4){0.f, 0.f, 0.f, 0.f}; z[64 + lane] = (f32x4){0.f, 0.f, 0.f, 0.f}; } }
        bf16* op = OPS + ((((size_t)b * NH + h) * (SEQ / 16) + (tpos >> 4)) * 7) * 1024 + (tpos & 15) * 32 + 8 * q;
        float k16[16]; ZSH16(tau, hp, 512 + hc, k16);
        float kinv;
        { float kk16[16]; PT16(PT_KK + hc, kk16); float ssq = 0.f;
#pragma unroll
          for (int i = 0; i < 16; ++i) { const float t = k16[i] * kk16[i]; ssq += t * t; }
          ssq = red4(ssq); kinv = 1.0f / fmaxf(sqrtf(ssq), 1e-12f); }
        { PREP_LORA(Bw, 0, 2); float wl[16], p0[16]; SW16(wl); PT16(PT_DW0 + hc, p0);
#pragma unroll
          for (int i = 0; i < 16; ++i) wl[i] = -0.60653066f * fsigmoid(wl[i] + p0[i]);
          ST16O(op + 1 * 1024, wl); }
        u32x4 K4a, K4b, K5a, K5b, G6a, G6b;
        { PREP_LORA(Ba, 64, 2); PREP_LDB(Bg, gupT, 128, 4); float al[16], p1[16], p3[16], o[16]; SW16(al); PT16(PT_IA0 + hc, p1); PT16(PT_KA + hc, p3);
#pragma unroll
          for (int i = 0; i < 16; ++i) { al[i] = fsigmoid(al[i] + p1[i]); o[i] = k16[i] * (1.0f + (al[i] - 1.0f) * p3[i]); }
          ST16O(op + 2 * 1024, o);
          { float r16[16]; ZSH16(tau, hp, hc, r16); ST16O(op + 0 * 1024, r16); PT16(PT_RK + hc, p3);
            float bs = 0.f;
#pragma unroll
            for (int i = 0; i < 16; ++i) bs += r16[i] * o[i] * p3[i];
            bs = red4(bs); if (q == 0) BON[((size_t)b * NH + h) * SEQ + tpos] = bs; }
#pragma unroll
          PT16(PT_KK + hc, p1);
#pragma unroll
          for (int i = 0; i < 16; ++i) { o[i] = k16[i] * p1[i] * kinv; al[i] = o[i] * al[i]; }
          K4a = __builtin_bit_cast(u32x4, pack8(*(const float(*)[8])&o[0])); K4b = __builtin_bit_cast(u32x4, pack8(*(const float(*)[8])&o[8]));
          K5a = __builtin_bit_cast(u32x4, pack8(*(const float(*)[8])&al[0])); K5b = __builtin_bit_cast(u32x4, pack8(*(const float(*)[8])&al[8])); }
        { PREP_LORA(Bg, 128, 4); if (l == 1) PREP_LDB(Bv, vruT, 32, 1); G6a = *(const LAS u32x4*)(sW + tau * 64 + 8 * q); G6b = *(const LAS u32x4*)(sW + tau * 64 + 8 * q + 32); }
        { float v16[16]; ZSH16(tau, hp, 1024 + hc, v16);
          if (l == 1) {
              float am8[8]; { const i32x4 a0 = *(const LAS i32x4*)(MAc + fr * 32 + 8 * kq), a1 = *(const LAS i32x4*)(MAc + fr * 32 + 8 * kq + 4);
#pragma unroll
                  for (int i = 0; i < 4; ++i) { am8[i] = (float)a0[i] * (1.0f / 262144.f); am8[4 + i] = (float)a1[i] * (1.0f / 262144.f); } }
              const bf16x8 am = pack8(am8);
#pragma unroll
              for (int nb = 0; nb < 4; ++nb) {
                  const f32x4 avr = __builtin_amdgcn_mfma_f32_16x16x32_bf16(am, Bv[nb][0], (f32x4){0.f, 0.f, 0.f, 0.f}, 0, 0, 0);
#pragma unroll
                  for (int j = 0; j < 4; ++j) sW[(4 * kq + j) * 64 + 16 * nb + fr] = (bf16)(cvt_pk_bf16(avr[j], 0.f) & 0xffffu); }
              LDS_WAIT(); asm volatile("" ::: "memory");
              float vl[16], vb[16], vf[16]; SW16(vl); PT16(PT_VRB + hc, vb); unpack8(vf0, *(float(*)[8])&vf[0]); unpack8(vf1, *(float(*)[8])&vf[8]);
#pragma unroll
              for (int i = 0; i < 16; ++i) v16[i] = v16[i] + (vf[i] - v16[i]) * fsigmoid(vb[i] + vl[i]);
          } else { ST16(VFIRST + tok * DR + hc, v16); }
          ST16O(op + 3 * 1024, v16); }
        asm volatile("" ::: "memory");
        *(u32x4*)(op + 4 * 1024) = K4a; *(u32x4*)(op + 4 * 1024 + 512) = K4b; *(u32x4*)(op + 5 * 1024) = K5a; *(u32x4*)(op + 5 * 1024 + 512) = K5b; *(u32x4*)(op + 6 * 1024) = G6a; *(u32x4*)(op + 6 * 1024 + 512) = G6b;
        asm volatile("" ::: "memory");
    }
#undef PREP_DMA
#undef PREP_LDR
#undef ZSH8
#undef ZSH16
#undef PREP_LORA
#undef PREP_LDB
#undef SW16
#undef PT16
#undef ST16
#undef ST16O
}

__device__ __forceinline__ NOPK void rec_phase(Frame& F, const Args& A, int l) {
    const bf16* OPS = (const bf16*)(F.ws + WS_OPS); bf16* YC = (bf16*)(F.ws + WS_YCAT);
    constexpr int TCH = 32, BUF_F = 7 * TCH * 64;
    LAS float* buf = (LAS float*)F.lds; LAS float* ybuf = (LAS float*)(F.lds + 2 * BUF_F * 4);
    const int v0 = 8 * F.wave + 2 * (F.lane >> 4), seg = F.lane & 15;
    for (int bh = F.bid; bh < BATCH * NH; bh += F.G) {
        const int b = bh >> 3, h = bh & 7;
        const bf16* src = OPS + (size_t)bh * SEQ * 448;
        f32x4 S0 = (f32x4){0.f, 0.f, 0.f, 0.f}, S1 = S0;
        u32x4 pre[4];
#define REC_ISSUE(c_) do { _Pragma("unroll") for (int i_ = 0; i_ < 4; ++i_) { const int p_ = F.tid + 512 * i_; if (p_ < 1792) pre[i_] = *(const u32x4*)(src + (size_t)(c_) * TCH * 448 + 8 * p_); } } while (0)
#define REC_LAND(c_) do { LAS float* d_ = buf + ((c_) & 1) * BUF_F; _Pragma("unroll") for (int i_ = 0; i_ < 4; ++i_) { const int p_ = F.tid + 512 * i_; if (p_ < 1792) { const int e0_ = 8 * p_, st_ = e0_ / 448, rem_ = e0_ % 448, arr_ = rem_ >> 6, col_ = rem_ & 63; \
            float f_[8]; unpack8(pre[i_], f_); LAS float* o_ = d_ + (arr_ * TCH + st_) * 64 + col_; *(LAS f32x4*)o_ = (f32x4){f_[0], f_[1], f_[2], f_[3]}; *(LAS f32x4*)(o_ + 4) = (f32x4){f_[4], f_[5], f_[6], f_[7]}; } } } while (0)
#define REC_LD(s_, KK, W, BB, KQ, RQ, VV) do { const LAS float* q_ = B + (s_) * 64 + 4 * seg; RQ = *(const LAS f32x4*)(q_); W = *(const LAS f32x4*)(q_ + 1 * TCH * 64); KQ = *(const LAS f32x4*)(q_ + 2 * TCH * 64); \
            KK = *(const LAS f32x4*)(q_ + 4 * TCH * 64); BB = *(const LAS f32x4*)(q_ + 5 * TCH * 64); VV = *(const LAS f32x2*)(B + (3 * TCH + (s_)) * 64 + v0); } while (0)
        const f32x4 rk = *(const f32x4*)(A.in[I_RK] + (size_t)l * DR + 64 * h + 4 * (F.tid & 15)), lw = *(const f32x4*)(A.in[I_LNW] + (size_t)l * DR + 64 * h + 4 * (F.tid & 15)), lb = *(const f32x4*)(A.in[I_LNB] + (size_t)l * DR + 64 * h + 4 * (F.tid & 15));
        REC_ISSUE(0); REC_LAND(0); LDS_BARRIER();
        for (int c = 0; c < SEQ / TCH; ++c) {
            if (c + 1 < SEQ / TCH) REC_ISSUE(c + 1);
            const LAS float* B = buf + (c & 1) * BUF_F;
            f32x4 kk, w, bb, kq, rq; f32x2 vv;
            REC_LD(0, kk, w, bb, kq, rq, vv);
#pragma unroll 4
            for (int s = 0; s < TCH; ++s) {
                f32x4 nkk, nw, nbb, nkq, nrq; f32x2 nvv;
                { const int sn = (s + 1 < TCH) ? s + 1 : s; REC_LD(sn, nkk, nw, nbb, nkq, nrq, nvv); }
                float p0 = (S0.x * kk.x + S0.y * kk.y) + (S0.z * kk.z + S0.w * kk.w);
                float p1 = (S1.x * kk.x + S1.y * kk.y) + (S1.z * kk.z + S1.w * kk.w);
                const f32x4 u0 = S0 * w + vv.x * kq, u1 = S1 * w + vv.y * kq;
                float U0 = (u0.x * rq.x + u0.y * rq.y) + (u0.z * rq.z + u0.w * rq.w);
                float U1 = (u1.x * rq.x + u1.y * rq.y) + (u1.z * rq.z + u1.w * rq.w);
                float Br = (bb.x * rq.x + bb.y * rq.y) + (bb.z * rq.z + bb.w * rq.w);
                p0 = red16(p0); p1 = red16(p1); U0 = red16(U0); U1 = red16(U1); Br = red16(Br);
                S0 = u0 - p0 * bb; S1 = u1 - p1 * bb;
                if (seg == 0) *(LAS f32x2*)(ybuf + s * 64 + v0) = (f32x2){U0 - p0 * Br, U1 - p1 * Br};
                kk = nkk; w = nw; bb = nbb; kq = nkq; rq = nrq; vv = nvv;
            }
            LDS_BARRIER();
            {
                const int st = F.tid >> 4, part = F.tid & 15, c4 = 4 * part;
                const f32x4 y4 = *(const LAS f32x4*)(ybuf + st * 64 + c4);
                const float mean = red16((y4.x + y4.y) + (y4.z + y4.w)) * (1.0f / 64.0f);
                const f32x4 dv = y4 - mean;
                const float var = red16((dv.x * dv.x + dv.y * dv.y) + (dv.z * dv.z + dv.w * dv.w)) * (1.0f / 64.0f);
                const float rstd = 1.0f / sqrtf(var + GN_EPS);
                const f32x4 r4 = *(const LAS f32x4*)(B + (0 * TCH + st) * 64 + c4), k4 = *(const LAS f32x4*)(B + (2 * TCH + st) * 64 + c4), v4 = *(const LAS f32x4*)(B + (3 * TCH + st) * 64 + c4), g4 = *(const LAS f32x4*)(B + (6 * TCH + st) * 64 + c4);
                const float bon = red16((r4.x * k4.x * rk.x + r4.y * k4.y * rk.y) + (r4.z * k4.z * rk.z + r4.w * k4.w * rk.w));
                const f32x4 o = (dv * rstd * lw + lb + bon * v4) * g4;
                u32x2 w; w.x = cvt_pk_bf16(o.x, o.y); w.y = cvt_pk_bf16(o.z, o.w);
                *(u32x2*)(YC + ((size_t)b * SEQ + c * TCH + st) * D + 64 * h + c4) = w;
            }
            if (c + 1 < SEQ / TCH) REC_LAND(c + 1);
            LDS_BARRIER();
        }
    }
}

__device__ __forceinline__ NOPK void attn_waves(Frame& F, const Args& A, int l, int wu0, int wustride) {
    const bf16* QN = (const bf16*)(F.ws + WS_QN); const bf16* KN = (const bf16*)(F.ws + WS_KN); const bf16* VF = (const bf16*)(F.ws + WS_VF); bf16* YC = (bf16*)(F.ws + WS_YCAT);
    const int qi = F.lane & 31, hh = F.lane >> 5;
    LAS unsigned char* stg = F.lds + 4 * 33536 + (F.wave - 4) * 4352;
    for (int wu = wu0; wu < BATCH * NH * 64; wu += wustride) {
        const int bh = wu >> 6, b = bh >> 3, h = bh & 7;
        const int Q0 = 32 * (wu & 63);
        bf16x8 qf[4];
#pragma unroll
        for (int ks = 0; ks < 4; ++ks) qf[ks] = *(const bf16x8*)(QN + ((size_t)bh * SEQ + Q0 + qi) * 64 + 16 * ks + 8 * hh);
        f32x16 O0, O1;
#pragma unroll
        for (int i = 0; i < 16; ++i) { O0[i] = 0.f; O1[i] = 0.f; }
        float R = 1.f;
        const int kbd = Q0 >> 5;
        for (int kb = kbd; kb >= 0; --kb) {
            bf16x8 kf[4], vf[2][2];
#pragma unroll
            for (int ks = 0; ks < 4; ++ks) kf[ks] = *(const bf16x8*)(KN + ((size_t)bh * SEQ + 32 * kb + qi) * 64 + 16 * ks + 8 * hh);
#pragma unroll
            for (int s = 0; s < 2; ++s)
#pragma unroll
                for (int db = 0; db < 2; ++db) vf[s][db] = *(const bf16x8*)(VF + ((((size_t)bh * 128 + 2 * kb + s) * 2 + hh) * 64 + qi + 32 * db) * 8);
            f32x16 Sx;
#pragma unroll
            for (int i = 0; i < 16; ++i) Sx[i] = 0.f;
#pragma unroll
            for (int ks = 0; ks < 4; ++ks) Sx = __builtin_amdgcn_mfma_f32_32x32x16_bf16(kf[ks], qf[ks], Sx, 0, 0, 0);
            const bool diag = (kb == kbd);
            float kp[16], sg[16];
#pragma unroll
            for (int i = 0; i < 16; ++i) { const int rho = (i & 3) + 8 * (i >> 2) + 4 * hh; const bool valid = !diag || rho < qi; const float L = Sx[i];
                const float e = __builtin_amdgcn_exp2f(-1.44269504f * fabsf(L)), r = __builtin_amdgcn_rcpf(1.0f + e), er = e * r; const bool pos = L >= 0.f;
                kp[i] = valid ? (pos ? er : r) : 1.f; sg[i] = valid ? (pos ? r : er) : 0.f; }
            float Cx[16], G[4], Pg[4];
#pragma unroll
            for (int gi = 0; gi < 4; ++gi) { const float x2 = kp[4 * gi + 3], x1 = x2 * kp[4 * gi + 2], x0 = x1 * kp[4 * gi + 1]; Cx[4 * gi + 3] = 1.f; Cx[4 * gi + 2] = x2; Cx[4 * gi + 1] = x1; Cx[4 * gi] = x0; G[gi] = x0 * kp[4 * gi]; }
#pragma unroll
            for (int gi = 0; gi < 4; ++gi) Pg[gi] = __shfl_xor(G[gi], 32);
            float T[4]; { const float sa2 = G[3], sa1 = sa2 * G[2], sa0 = sa1 * G[1], sb2 = Pg[3], sb1 = sb2 * Pg[2], sb0 = sb1 * Pg[1];
                T[3] = 1.f; T[2] = sa2 * sb2; T[1] = sa1 * sb1; T[0] = sa0 * sb0;
                if (hh == 0) { T[3] *= Pg[3]; T[2] *= Pg[2]; T[1] *= Pg[1]; T[0] *= Pg[0]; } }
            const float tot = ((G[0] * G[1]) * (G[2] * G[3])) * ((Pg[0] * Pg[1]) * (Pg[2] * Pg[3]));
            float wg[16];
#pragma unroll
            for (int i = 0; i < 16; ++i) wg[i] = sg[i] * Cx[i] * (T[i >> 2] * R);
            R *= tot;
            const bf16x8 p0 = pack8(*(float(*)[8])&wg[0]), p1 = pack8(*(float(*)[8])&wg[8]);
            O0 = __builtin_amdgcn_mfma_f32_32x32x16_bf16(vf[0][0], p0, O0, 0, 0, 0); O1 = __builtin_amdgcn_mfma_f32_32x32x16_bf16(vf[0][1], p0, O1, 0, 0, 0);
            O0 = __builtin_amdgcn_mfma_f32_32x32x16_bf16(vf[1][0], p1, O0, 0, 0, 0); O1 = __builtin_amdgcn_mfma_f32_32x32x16_bf16(vf[1][1], p1, O1, 0, 0, 0);
            if (__all(R < 9.3576e-14f)) break;
        }
        float ss = 0.f;
#pragma unroll
        for (int i = 0; i < 16; ++i) ss += O0[i] * O0[i] + O1[i] * O1[i];
        ss += __shfl_xor(ss, 32);
        const float rstd = 1.0f / sqrtf(ss * (1.0f / 64.0f) + NORM_EPS);
        const float* og = A.in[I_SBG] + (size_t)l * DR + 64 * h;
#pragma unroll
        for (int db = 0; db < 2; ++db)
#pragma unroll
            for (int gi = 0; gi < 4; ++gi) { const int d = 32 * db + 8 * gi + 4 * hh; const f32x4 gq = *(const f32x4*)(og + d);
                const float o0 = (db ? O1[4 * gi] : O0[4 * gi]) * rstd * gq.x, o1 = (db ? O1[4 * gi + 1] : O0[4 * gi + 1]) * rstd * gq.y, o2 = (db ? O1[4 * gi + 2] : O0[4 * gi + 2]) * rstd * gq.z, o3 = (db ? O1[4 * gi + 3] : O0[4 * gi + 3]) * rstd * gq.w;
                u32x2 w; w.x = cvt_pk_bf16(o0, o1); w.y = cvt_pk_bf16(o2, o3); *(LAS u32x2*)(stg + qi * 136 + d * 2) = w; }
        LDS_WAIT(); asm volatile("" ::: "memory");
#pragma unroll
        for (int k = 0; k < 4; ++k) { const int row = 8 * k + (F.lane >> 3), un8 = F.lane & 7;
            const u32x2 lo_ = *(const LAS u32x2*)(stg + row * 136 + un8 * 16), hi_ = *(const LAS u32x2*)(stg + row * 136 + un8 * 16 + 8);
            *(u32x4*)(YC + ((size_t)b * SEQ + Q0 + row) * D + 512 + 64 * h + un8 * 8) = (u32x4){lo_.x, lo_.y, hi_.x, hi_.y}; }
        LDS_WAIT(); asm volatile("" ::: "memory");
    }
}

constexpr int CL = 32, NCH = SEQ / CL, CH_ELEMS = 12288;
constexpr size_t WS_CH = WS_Z;
#define CH_SWZ(row, col) (((((col) >> 3) ^ ((row) & 7)) << 3) | ((col) & 7))
constexpr int C1_LDS = 33536; static_assert(4 * C1_LDS + 4 * 4352 <= MISC_OFF, "c1 + attention staging LDS");
__device__ __forceinline__ NOPK bf16x8 acc_frag(const f32x16& a, int s) {
    float f[8];
#pragma unroll
    for (int i = 0; i < 8; ++i) f[i] = a[8 * s + i];
    return pack8(f);
}
__device__ __forceinline__ NOPK void c1_unit(Frame& F, int l, int bh, int c, LAS unsigned char* wl) {
    const bf16* OPS = (const bf16*)(F.ws + WS_OPS) + ((size_t)bh * SEQ + (size_t)c * CL) * 448;
    bf16* CH = (bf16*)(F.ws + WS_CH) + ((size_t)bh * NCH + c) * CH_ELEMS;
    constexpr int IP = 40, RP = 72, TP = 72;
    LAS bf16* KT = (LAS bf16*)wl; LAS bf16* VT = KT + 64 * IP; LAS bf16* KbT = VT + 64 * IP; LAS bf16* BbT = KbT + 64 * IP;
    LAS bf16* RtI = BbT + 64 * IP; LAS bf16* WvI = RtI + 32 * RP; LAS bf16* XI = WvI + 64 * IP; LAS float* cLs = (LAS float*)(WvI + 4096);
    LAS float* TB = (LAS float*)WvI;
    const int lane = F.lane, t = lane & 31, h = lane >> 5;
    const int trq = (lane & 15) >> 2, trp = lane & 3, trb = (lane >> 4) & 1;
#pragma unroll
    for (int n = 0; n < 4; ++n) { float w8[8]; unpack8(*(const u32x4*)(OPS + (t >> 4) * 7168 + 1 * 1024 + (n >> 1) * 512 + (t & 15) * 32 + 8 * (h + 2 * (n & 1))), w8);
        *(LAS f32x4*)(TB + t * 64 + 8 * (h + 2 * n)) = (f32x4){w8[0], w8[1], w8[2], w8[3]}; *(LAS f32x4*)(TB + t * 64 + 8 * (h + 2 * n) + 4) = (f32x4){w8[4], w8[5], w8[6], w8[7]}; }
    u32x4 rw[5][4];
#pragma unroll
    for (int a = 0; a < 5; ++a)
#pragma unroll
        for (int n = 0; n < 4; ++n) rw[a][n] = *(const u32x4*)(OPS + (t >> 4) * 7168 + (a == 0 ? 0 : a + 1) * 1024 + (n >> 1) * 512 + (t & 15) * 32 + 8 * (h + 2 * (n & 1)));
    LDS_WAIT(); asm volatile("" ::: "memory");
    float cLl;
    { float cs = 0.f;
#pragma unroll 8
      for (int s = 0; s < CL; ++s) { cs += TB[s * 64 + lane]; TB[s * 64 + lane] = cs; }
      cLl = cs; }
    LDS_WAIT(); asm volatile("" ::: "memory");
    bf16x8 fKap[4], fBt[4], fKt[4], fRt[4];
#pragma unroll
    for (int n = 0; n < 4; ++n) { const int j0 = 8 * (h + 2 * n);
        float ct[8], cp[8], cl[8]; lds8f(TB + t * 64 + j0, ct); lds8f(TB + 31 * 64 + j0, cl);
        if (t > 0) lds8f(TB + (t - 1) * 64 + j0, cp); else {
#pragma unroll
            for (int i = 0; i < 8; ++i) cp[i] = 0.f; }
        float r8[8], k8[8], ka8[8], be8[8], x[8];
        unpack8(rw[0][n], r8); unpack8(rw[1][n], k8); unpack8(rw[3][n], ka8); unpack8(rw[4][n], be8);
        float ep[8], en[8], ed[8], eq[8];
#pragma unroll
        for (int i = 0; i < 8; ++i) { ep[i] = __expf(ct[i]); en[i] = __expf(-ct[i]); ed[i] = __expf(cl[i] - ct[i]); eq[i] = __expf(cp[i]); }
#pragma unroll
        for (int i = 0; i < 8; ++i) x[i] = ka8[i] * eq[i];
        fKap[n] = pack8(x); *(LAS u32x4*)(KT + t * TP + j0) = __builtin_bit_cast(u32x4, fKap[n]);
#pragma unroll
        for (int i = 0; i < 8; ++i) x[i] = be8[i] * en[i];
        fBt[n] = pack8(x);
#pragma unroll
        for (int i = 0; i < 8; ++i) x[i] = k8[i] * en[i];
        fKt[n] = pack8(x);
#pragma unroll
        for (int i = 0; i < 8; ++i) x[i] = r8[i] * ep[i];
        fRt[n] = pack8(x); *(LAS u32x4*)(RtI + t * RP + j0) = __builtin_bit_cast(u32x4, fRt[n]);
        *(LAS u32x4*)(VT + t * TP + j0) = rw[2][n];
#pragma unroll
        for (int i = 0; i < 8; ++i) x[i] = k8[i] * ed[i];
        *(LAS u32x4*)(KbT + t * TP + j0) = __builtin_bit_cast(u32x4, pack8(x));
#pragma unroll
        for (int i = 0; i < 8; ++i) x[i] = be8[i] * ed[i];
        *(LAS u32x4*)(BbT + t * TP + j0) = __builtin_bit_cast(u32x4, pack8(x));
        asm volatile("" ::: "memory"); }
    LDS_WAIT(); asm volatile("" ::: "memory");
    cLs[lane] = cLl;
    LDS_WAIT(); asm volatile("" ::: "memory");
    const f32x16 Z16 = {0.f, 0.f, 0.f, 0.f, 0.f, 0.f, 0.f, 0.f, 0.f, 0.f, 0.f, 0.f, 0.f, 0.f, 0.f, 0.f};
#define C1_ROW(i) (((i) & 3) + 8 * ((i) >> 2) + 4 * h)
#define C1_PUT(IMG, PITCH, ROW0, ACC) do { _Pragma("unroll") for (int g_ = 0; g_ < 4; ++g_) { u32x2 w_; w_.x = cvt_pk_bf16(ACC[4 * g_], ACC[4 * g_ + 1]); w_.y = cvt_pk_bf16(ACC[4 * g_ + 2], ACC[4 * g_ + 3]); \
        *(LAS u32x2*)(IMG + t * (PITCH) + (ROW0) + 8 * g_ + 4 * h) = w_; } LDS_WAIT(); asm volatile("" ::: "memory"); } while (0)
#define C1_TR(P_) __builtin_amdgcn_ds_read_tr16_b64_v4i16((LAS s16x4*)(P_))
#define C1_GETA(IMG, PITCH, ROW0, ks) ({ LAS bf16* b_ = (LAS bf16*)(IMG) + (16 * (ks) + 4 * h + trq) * (PITCH) + (ROW0) + 16 * trb + 4 * trp; const s16x4 lo_ = C1_TR(b_), hi_ = C1_TR(b_ + 8 * (PITCH)); \
        (bf16x8){lo_.x, lo_.y, lo_.z, lo_.w, hi_.x, hi_.y, hi_.z, hi_.w}; })
    f32x16 P = Z16;
#pragma unroll
    for (int ks = 0; ks < 4; ++ks) P = __builtin_amdgcn_mfma_f32_32x32x16_bf16(fBt[ks], fKap[ks], P, 0, 0, 0);
    f32x16 T;
#pragma unroll
    for (int i = 0; i < 16; ++i) { const int row = C1_ROW(i); P[i] = row < t ? -P[i] : 0.f; T[i] = P[i] + (row == t ? 1.f : 0.f); }
    C1_PUT(XI, IP, 0, P);
    bf16x8 aP0 = C1_GETA(XI, IP, 0, 0), aP1 = C1_GETA(XI, IP, 0, 1);
    LDS_WAIT(); asm volatile("" ::: "memory");
#pragma unroll 1
    for (int it = 0; it < 4; ++it) {
        const bf16x8 bP0 = acc_frag(P, 0), bP1 = acc_frag(P, 1);
        P = __builtin_amdgcn_mfma_f32_32x32x16_bf16(aP0, bP0, Z16, 0, 0, 0); P = __builtin_amdgcn_mfma_f32_32x32x16_bf16(aP1, bP1, P, 0, 0, 0);
        C1_PUT(XI, IP, 0, P);
        aP0 = C1_GETA(XI, IP, 0, 0); aP1 = C1_GETA(XI, IP, 0, 1);
        LDS_WAIT(); asm volatile("" ::: "memory");
        const bf16x8 bT0 = acc_frag(T, 0), bT1 = acc_frag(T, 1);
        T = __builtin_amdgcn_mfma_f32_32x32x16_bf16(aP0, bT0, T, 0, 0, 0); T = __builtin_amdgcn_mfma_f32_32x32x16_bf16(aP1, bT1, T, 0, 0, 0);
    }
    const bf16x8 bT0 = acc_frag(T, 0), bT1 = acc_frag(T, 1);
    f32x16 Akk = Z16, Qkr = Z16, Qbr = Z16;
#pragma unroll
    for (int ks = 0; ks < 4; ++ks) { Akk = __builtin_amdgcn_mfma_f32_32x32x16_bf16(fKt[ks], fKap[ks], Akk, 0, 0, 0); Qkr = __builtin_amdgcn_mfma_f32_32x32x16_bf16(fKt[ks], fRt[ks], Qkr, 0, 0, 0);
                                    Qbr = __builtin_amdgcn_mfma_f32_32x32x16_bf16(fBt[ks], fRt[ks], Qbr, 0, 0, 0); }
#pragma unroll
    for (int i = 0; i < 16; ++i) { const int row = C1_ROW(i); Akk[i] = row < t ? Akk[i] : 0.f; Qkr[i] = row <= t ? Qkr[i] : 0.f; Qbr[i] = row <= t ? Qbr[i] : 0.f; }
    const bf16x8 bQkr0 = acc_frag(Qkr, 0), bQkr1 = acc_frag(Qkr, 1), bQbr0 = acc_frag(Qbr, 0), bQbr1 = acc_frag(Qbr, 1);
    C1_PUT(XI, IP, 0, Akk);
    bf16x8 bM0, bM1;
    { const bf16x8 a0 = C1_GETA(XI, IP, 0, 0), a1 = C1_GETA(XI, IP, 0, 1);
      f32x16 M1 = __builtin_amdgcn_mfma_f32_32x32x16_bf16(a0, bT0, Z16, 0, 0, 0); M1 = __builtin_amdgcn_mfma_f32_32x32x16_bf16(a1, bT1, M1, 0, 0, 0);
      bM0 = acc_frag(M1, 0); bM1 = acc_frag(M1, 1); }
    bf16x8 aKh[2][2];
    { const bf16x8 a00 = C1_GETA(KT, TP, 0, 0), a01 = C1_GETA(KT, TP, 0, 1), a10 = C1_GETA(KT, TP, 32, 0), a11 = C1_GETA(KT, TP, 32, 1);
      LDS_WAIT(); asm volatile("" ::: "memory");
      f32x16 k0 = __builtin_amdgcn_mfma_f32_32x32x16_bf16(a00, bT0, Z16, 0, 0, 0); k0 = __builtin_amdgcn_mfma_f32_32x32x16_bf16(a01, bT1, k0, 0, 0, 0);
      f32x16 k1 = __builtin_amdgcn_mfma_f32_32x32x16_bf16(a10, bT0, Z16, 0, 0, 0); k1 = __builtin_amdgcn_mfma_f32_32x32x16_bf16(a11, bT1, k1, 0, 0, 0);
      C1_PUT(KT, TP, 0, k0); C1_PUT(KT, TP, 32, k1);
#pragma unroll
      for (int jb = 0; jb < 2; ++jb)
#pragma unroll
          for (int ks = 0; ks < 2; ++ks) aKh[jb][ks] = C1_GETA(KT, TP, 32 * jb, ks); }
    bf16x8 aVT[2][2], aWv[2][2];
#pragma unroll
    for (int vb = 0; vb < 2; ++vb)
#pragma unroll
        for (int ks = 0; ks < 2; ++ks) aVT[vb][ks] = C1_GETA(VT, TP, 32 * vb, ks);
    { f32x16 w0 = __builtin_amdgcn_mfma_f32_32x32x16_bf16(aVT[0][0], bM0, Z16, 0, 0, 0); w0 = __builtin_amdgcn_mfma_f32_32x32x16_bf16(aVT[0][1], bM1, w0, 0, 0, 0);
      f32x16 w1 = __builtin_amdgcn_mfma_f32_32x32x16_bf16(aVT[1][0], bM0, Z16, 0, 0, 0); w1 = __builtin_amdgcn_mfma_f32_32x32x16_bf16(aVT[1][1], bM1, w1, 0, 0, 0);
      C1_PUT(WvI, TP, 0, w0); C1_PUT(WvI, TP, 32, w1);
#pragma unroll
      for (int vb = 0; vb < 2; ++vb)
#pragma unroll
          for (int ks = 0; ks < 2; ++ks) aWv[vb][ks] = C1_GETA(WvI, TP, 32 * vb, ks); }
    LDS_WAIT(); asm volatile("" ::: "memory");
    LAS bf16* STG = (LAS bf16*)wl;
#define C1_ST4(BLK, ROWL, COL, a0_, a1_, a2_, a3_) do { u32x2 w_; w_.x = cvt_pk_bf16(a0_, a1_); w_.y = cvt_pk_bf16(a2_, a3_); *(LAS u32x2*)(STG + ((BLK) & 1) * 2048 + (ROWL) * 64 + CH_SWZ(ROWL, COL)) = w_; } while (0)
#define C1_FLUSH(BLK, GOFF) do { LDS_WAIT(); asm volatile("" ::: "memory"); _Pragma("unroll") for (int k_ = 0; k_ < 4; ++k_) { const u32x4 w_ = *(const LAS u32x4*)(STG + ((BLK) & 1) * 2048 + (k_ * 64 + lane) * 8); \
        *(u32x4*)(CH + (GOFF) + (k_ * 64 + lane) * 8) = w_; } } while (0)
#pragma unroll
    for (int jb = 0; jb < 2; ++jb) { f32x16 a = __builtin_amdgcn_mfma_f32_32x32x16_bf16(aKh[jb][0], bQbr0, Z16, 0, 0, 0); a = __builtin_amdgcn_mfma_f32_32x32x16_bf16(aKh[jb][1], bQbr1, a, 0, 0, 0);
#pragma unroll
        for (int g = 0; g < 4; ++g) { const int j0 = 32 * jb + 8 * g + 4 * h; const u32x2 rv = *(const LAS u32x2*)(RtI + t * RP + j0);
            C1_ST4(0, t, j0, bflo(rv.x) - a[4 * g], bfhi(rv.x) - a[4 * g + 1], bflo(rv.y) - a[4 * g + 2], bfhi(rv.y) - a[4 * g + 3]); } }
    C1_FLUSH(0, 8192);
#pragma unroll
    for (int vb = 0; vb < 2; ++vb) { f32x16 a = __builtin_amdgcn_mfma_f32_32x32x16_bf16(aVT[vb][0], bQkr0, Z16, 0, 0, 0); a = __builtin_amdgcn_mfma_f32_32x32x16_bf16(aVT[vb][1], bQkr1, a, 0, 0, 0);
        f32x16 s = __builtin_amdgcn_mfma_f32_32x32x16_bf16(aWv[vb][0], bQbr0, Z16, 0, 0, 0); s = __builtin_amdgcn_mfma_f32_32x32x16_bf16(aWv[vb][1], bQbr1, s, 0, 0, 0);
#pragma unroll
        for (int g = 0; g < 4; ++g) { const int v0 = 32 * vb + 8 * g + 4 * h; C1_ST4(1, t, v0, a[4 * g] - s[4 * g], a[4 * g + 1] - s[4 * g + 1], a[4 * g + 2] - s[4 * g + 2], a[4 * g + 3] - s[4 * g + 3]); } }
    C1_FLUSH(1, 10240);
#pragma unroll
    for (int jc = 0; jc < 2; ++jc) { const bf16x8 bB0 = C1_GETA(BbT, TP, 32 * jc, 0), bB1 = C1_GETA(BbT, TP, 32 * jc, 1), bK0 = C1_GETA(KbT, TP, 32 * jc, 0), bK1 = C1_GETA(KbT, TP, 32 * jc, 1);
        const int jp = 32 * jc + t; const float gl = __expf(cLs[jp]);
#pragma unroll
        for (int jb = 0; jb < 2; ++jb) { f32x16 a = __builtin_amdgcn_mfma_f32_32x32x16_bf16(aKh[jb][0], bB0, Z16, 0, 0, 0); a = __builtin_amdgcn_mfma_f32_32x32x16_bf16(aKh[jb][1], bB1, a, 0, 0, 0);
#pragma unroll
            for (int g = 0; g < 4; ++g) { const int j0 = 32 * jb + 8 * g + 4 * h; float o[4];
#pragma unroll
                for (int e = 0; e < 4; ++e) o[e] = ((j0 + e) == jp ? gl : 0.f) - a[4 * g + e];
                C1_ST4(0, t, j0, o[0], o[1], o[2], o[3]); } }
        C1_FLUSH(0, jc * 2048);
#pragma unroll
        for (int vb = 0; vb < 2; ++vb) { f32x16 a = __builtin_amdgcn_mfma_f32_32x32x16_bf16(aVT[vb][0], bK0, Z16, 0, 0, 0); a = __builtin_amdgcn_mfma_f32_32x32x16_bf16(aVT[vb][1], bK1, a, 0, 0, 0);
            f32x16 s = __builtin_amdgcn_mfma_f32_32x32x16_bf16(aWv[vb][0], bB0, Z16, 0, 0, 0); s = __builtin_amdgcn_mfma_f32_32x32x16_bf16(aWv[vb][1], bB1, s, 0, 0, 0);
#pragma unroll
            for (int g = 0; g < 4; ++g) { const int v0 = 32 * vb + 8 * g + 4 * h; C1_ST4(1, t, v0, a[4 * g] - s[4 * g], a[4 * g + 1] - s[4 * g + 1], a[4 * g + 2] - s[4 * g + 2], a[4 * g + 3] - s[4 * g + 3]); } }
        C1_FLUSH(1, 4096 + jc * 2048); }
    LDS_WAIT(); asm volatile("" ::: "memory");
#undef C1_ROW
#undef C1_PUT
#undef C1_GETA
#undef C1_TR
#undef C1_ST4
#undef C1_FLUSH
}
__device__ __forceinline__ NOPK void c2_phase(Frame& F, const Args& A, int l) {
    const bf16* OPS = (const bf16*)(F.ws + WS_OPS); const bf16* CHB = (const bf16*)(F.ws + WS_CH); bf16* YC = (bf16*)(F.ws + WS_YCAT);
    constexpr int NSLOT = 5, SLOT_B = CH_ELEMS * 2, DEPTH_C = 4, PER_W = 12;
    LAS float* ybuf = (LAS float*)(F.lds + NSLOT * SLOT_B);
    static_assert(NSLOT * SLOT_B + 3 * 8192 <= MISC_OFF, "c2 LDS map");
    const int qi = F.lane & 31, hh = F.lane >> 5, vb32 = 32 * F.wave;
    const f32x16 Z16 = {0.f, 0.f, 0.f, 0.f, 0.f, 0.f, 0.f, 0.f, 0.f, 0.f, 0.f, 0.f, 0.f, 0.f, 0.f, 0.f};
    bf16x8 idn[2];
#pragma unroll
    for (int ks = 0; ks < 2; ++ks) { float f[8];
#pragma unroll
        for (int j = 0; j < 8; ++j) f[j] = (16 * ks + 8 * hh + j == qi) ? 1.0f : 0.f;
        idn[ks] = pack8(f); }
    const int pidx = (F.tid - 128) & 255, st = pidx >> 3, c8 = 8 * (pidx & 7); const bool loader = F.wave >= 6, chain = F.wave < 2;
    for (int bh = F.bid; bh < BATCH * NH; bh += F.G) {
        const int b = bh >> 3, h = bh & 7;
        if (chain) {
            f32x16 S0 = Z16, S1 = Z16;
            LDS_BARRIER();
            for (int c = 0; c <= NCH; ++c) {
                if (c < NCH) {
                    const LAS bf16* sl = (const LAS bf16*)(F.lds + (c % NSLOT) * SLOT_B);
#define C2_GETP(OFF, ROW, ks) ({ const u32x2 lo_ = *(const LAS u32x2*)(sl + (OFF) + (ROW) * 64 + CH_SWZ(ROW, 16 * (ks) + 4 * hh)), hi_ = *(const LAS u32x2*)(sl + (OFF) + (ROW) * 64 + CH_SWZ(ROW, 16 * (ks) + 8 + 4 * hh)); \
                        const u32x4 w_ = {lo_.x, lo_.y, hi_.x, hi_.y}; __builtin_bit_cast(bf16x8, w_); })
#define C2_GETN(OFF, ROW, ks) (*(const LAS bf16x8*)(sl + (OFF) + (ROW) * 64 + CH_SWZ(ROW, vb32 + 16 * (ks) + 8 * hh)))
                    bf16x8 sf[4]; sf[0] = acc_frag(S0, 0); sf[1] = acc_frag(S0, 1); sf[2] = acc_frag(S1, 0); sf[3] = acc_frag(S1, 1);
                    f32x16 Y = Z16, N0 = Z16, N1 = Z16;
#pragma unroll
                    for (int ks = 0; ks < 2; ++ks) { Y = __builtin_amdgcn_mfma_f32_32x32x16_bf16(C2_GETN(10240, qi, ks), idn[ks], Y, 0, 0, 0); N0 = __builtin_amdgcn_mfma_f32_32x32x16_bf16(C2_GETN(4096, qi, ks), idn[ks], N0, 0, 0, 0);
                                                    N1 = __builtin_amdgcn_mfma_f32_32x32x16_bf16(C2_GETN(4096, 32 + qi, ks), idn[ks], N1, 0, 0, 0); }
#pragma unroll
                    for (int ks = 0; ks < 4; ++ks) { Y = __builtin_amdgcn_mfma_f32_32x32x16_bf16(C2_GETP(8192, qi, ks), sf[ks], Y, 0, 0, 0);
                        N0 = __builtin_amdgcn_mfma_f32_32x32x16_bf16(C2_GETP(0, qi, ks), sf[ks], N0, 0, 0, 0); N1 = __builtin_amdgcn_mfma_f32_32x32x16_bf16(C2_GETP(0, 32 + qi, ks), sf[ks], N1, 0, 0, 0); }
                    LAS float* yb = ybuf + (c % 3) * 2048;
#pragma unroll
                    for (int i = 0; i < 16; ++i) { const int row = (i & 3) + 8 * (i >> 2) + 4 * hh; yb[row * 64 + vb32 + qi] = Y[i]; }
                    S0 = N0; S1 = N1;
#undef C2_GETP
#undef C2_GETN
                }
                LDS_BARRIER();
            }
            LDS_BARRIER();
        } else if (loader) {
#define C2_DMA(cidx) do { const bf16* ch_ = CHB + ((size_t)bh * NCH + (cidx)) * CH_ELEMS; LAS unsigned char* sl_ = F.lds + ((cidx) % NSLOT) * SLOT_B; \
            _Pragma("unroll") for (int k_ = 0; k_ < PER_W; ++k_) { const int i_ = (F.wave - 6) + 2 * k_; \
                __builtin_amdgcn_global_load_lds((const unsigned*)(ch_ + i_ * 512 + F.lane * 8), (LAS unsigned*)(sl_ + i_ * 1024), 16, 0, 0); } } while (0)
#pragma unroll 1
            for (int cc = 0; cc < DEPTH_C; ++cc) C2_DMA(cc);
            asm volatile("s_waitcnt vmcnt(36)" ::: "memory");
            LDS_BARRIER();
            for (int c = 0; c <= NCH; ++c) {
                if (c + DEPTH_C < NCH) { C2_DMA(c + DEPTH_C); asm volatile("s_waitcnt vmcnt(36)" ::: "memory"); }
                else if (c + 3 < NCH) asm volatile("s_waitcnt vmcnt(24)" ::: "memory");
                else if (c + 2 < NCH) asm volatile("s_waitcnt vmcnt(12)" ::: "memory");
                else asm volatile("s_waitcnt vmcnt(0)" ::: "memory");
                LDS_BARRIER();
            }
            LDS_BARRIER();
#undef C2_DMA
        } else {
            float plw[8], plb[8]; const float* BON = (const float*)(F.ws + WS_BON);
            ld8f(A.in[I_LNW] + (size_t)l * DR + 64 * h + c8, plw); ld8f(A.in[I_LNB] + (size_t)l * DR + 64 * h + c8, plb);
            u32x4 pv, pg, qv, qg; float pb = 0.f, qb = 0.f;
            LDS_BARRIER();
            for (int c = 0; c <= NCH; ++c) {
                if (c < NCH) { const bf16* op = OPS + ((size_t)bh * SEQ + c * CL) * 448 + (st >> 4) * 7168 + (c8 >> 5) * 512 + (st & 15) * 32 + (c8 & 31);
                    qv = *(const u32x4*)(op + 3 * 1024); qg = *(const u32x4*)(op + 6 * 1024); qb = BON[(size_t)bh * SEQ + c * CL + st]; }
                LDS_BARRIER();
                if (c > 0) {
                    const int cc = c - 1; const LAS float* yb = ybuf + (cc % 3) * 2048;
                    float y[8], v8[8], g8[8]; lds8f(yb + st * 64 + c8, y); unpack8(pv, v8); unpack8(pg, g8);
                    float s_ = 0.f;
#pragma unroll
                    for (int i = 0; i < 8; ++i) s_ += y[i];
                    const float mean = red8(s_) * (1.0f / 64.0f); float q = 0.f;
#pragma unroll
                    for (int i = 0; i < 8; ++i) { y[i] -= mean; q += y[i] * y[i]; }
                    const float rstd = 1.0f / sqrtf(red8(q) * (1.0f / 64.0f) + GN_EPS); const float bon = pb;
#pragma unroll
                    for (int i = 0; i < 8; ++i) y[i] = (y[i] * rstd * plw[i] + plb[i] + bon * v8[i]) * g8[i];
                    *(u32x4*)(YC + ((size_t)b * SEQ + cc * CL + st) * D + 64 * h + c8) = __builtin_bit_cast(u32x4, pack8(y));
                }
                pv = qv; pg = qg; pb = qb;
            }
            LDS_BARRIER();
        }
    }
}
__device__ __forceinline__ NOPK void c1a_phase(Frame& F, const Args& A, int l) {
    if (F.wave < 4) {
        LAS unsigned char* wl = F.lds + F.wave * C1_LDS;
        const int gw = F.bid * 4 + F.wave, NGW = F.G * 4;
        for (int u = gw; u < BATCH * NH * NCH; u += NGW) c1_unit(F, l, u >> 6, u & 63, wl);
    } else {
        attn_waves(F, A, l, F.bid * 4 + (F.wave - 4), F.G * 4);
    }
}

__global__ void __launch_bounds__(512, 2) NOPK mk_fwd(Args args) {
    extern __shared__ __attribute__((aligned(16))) unsigned char lds_raw[];
    Frame F;
    F.lds = (LAS unsigned char*)lds_raw;
    const int wave_s = __builtin_amdgcn_readfirstlane((int)threadIdx.x >> 6);
#define TID_NOW() ({ unsigned m_ = ~0u; asm volatile("" : "+s"(m_)); wave_s * 64 + (int)__builtin_amdgcn_mbcnt_hi(m_, __builtin_amdgcn_mbcnt_lo(m_, 0u)); })
    F.tid = TID_NOW(); F.lane = F.tid & 63; F.wave = wave_s; F.G = gridDim.x; F.bid = blockIdx.x;
    F.out = args.out; F.ws = args.ws;
    volatile LAS unsigned* MISC = (volatile LAS unsigned*)(F.lds + MISC_OFF);
    if (F.tid < 64) MISC[F.tid] = 0u;
    __syncthreads();
    const int lo = args.ph_lo, hi = args.ph_hi;
    unsigned* barw = (unsigned*)(F.ws + WS_CTL) + CW_BAR;
    XcdBarrier bar; bar.bar = barw; bar.x = 0; bar.st = nullptr;
    if (hi - lo > 1) bar = xcd_barrier_post(barw, MISC + 8, F.tid);
#define IN(k) (lo <= (k) && (k) < hi)
#define FRESH() do { F.tid = TID_NOW(); asm volatile("" : "+v"(F.tid)); F.lane = F.tid & 63; F.wave = wave_s; } while (0)
#define SEAM(k) do { if (IN(k) && IN((k) + 1)) { FRESH(); xcd_barrier(bar, F.tid); } } while (0)
constexpr int WGM_IN = 4, WGM_OUT = 8;
#ifndef PROBE_DUP
#define PROBE_DUP -1
#endif
#define SITE(k, ...) do { if (IN(k)) { __VA_ARGS__ if constexpr (PROBE_DUP >= 0) { if (PROBE_DUP == (k)) { __syncthreads(); __VA_ARGS__ } } } } while (0)
#define SITE2(k, code, ...) do { if (IN(k)) { __VA_ARGS__ if constexpr (PROBE_DUP >= 0) { if (PROBE_DUP == (code)) { __syncthreads(); __VA_ARGS__ } } } } while (0)
    SITE(0, FRESH(); p0_prologue(F, args);); SEAM(0);
    for (int l = 0; l < DEPTH; ++l) {
        const int p = 1 + 9 * l;
        SITE(p + 0, FRESH(); if (l == 0) norm_phase<0>(F, args, 0); else norm_phase<1>(F, args, 1);); SEAM(p + 0);
        SITE(p + 1,
            { FRESH(); pg8::Gemm g{(const bf16*)(F.ws + WS_H), (const bf16*)(F.ws + WS_WIN) + (size_t)l * C_IN * D, D}; pg8::StaticOrder<WGM_IN> S; S.init(M, C_IN, F.G, F.bid);
            pg8::EpiBf16 E{(bf16*)(F.ws + WS_Z), C_IN};
            pg8::gemm_phase<pg8::EpiBf16, pg8::StaticOrder<WGM_IN>, false>(F.lds, g, S, E, F.tid); }); SEAM(p + 1);
        SITE(p + 2, FRESH(); prep_phase(F, args, l);); SEAM(p + 2);
        SITE(p + 3, FRESH(); c1a_phase(F, args, l);); SEAM(p + 3);
        SITE(p + 4, FRESH(); c2_phase(F, args, l);); SEAM(p + 4);
        SITE(p + 5,
            { FRESH(); pg8::Gemm g{(const bf16*)(F.ws + WS_YCAT), (const bf16*)(F.ws + WS_WOUT) + (size_t)l * D * D, D}; pg8::StaticOrder<WGM_OUT> S; S.init(M, D, F.G, F.bid);
            pg8::EpiResid E{l == 0 ? args.in[I_X] : F.out, (bf16*)(F.ws + WS_X1), (const float*)(F.ws + WS_MOD) + (size_t)l * 32 * 6144 + 2048};
            pg8::gemm_phase<pg8::EpiResid, pg8::StaticOrder<WGM_OUT>, false>(F.lds, g, S, E, F.tid); }); SEAM(p + 5);
        SITE(p + 6, FRESH(); n2r_phase(F, args, l););
        if constexpr (PROBE_DUP == 6) { if (l == 0 && IN(p + 6)) { xcd_barrier(bar, F.tid); if (F.bid == 0 && F.tid < 32) ((unsigned*)(F.ws + WS_CTL))[CW_CNT + F.tid] = 0u; xcd_barrier(bar, F.tid); FRESH(); n2r_phase(F, args, l); } }
        SEAM(p + 6);
        SITE(p + 7,
            { FRESH(); build_tab(F, l);
            pg8::Gemm g{(const bf16*)(F.ws + WS_H), (const bf16*)(F.ws + WS_W1 + (size_t)l * NE * 2048 * D), D / 2};
            pg8::MoeOrder<8> S; S.init((const LAS int*)(F.lds + TAB_OFF), (const int*)(F.ws + WS_ROWTOK), F.G, F.bid, D);
            pg8::EpiSwiglu E{F.ws + WS_ACT, args.in[I_B1] + (size_t)l * NE * 2048};
            pg8::gemm_phase<pg8::EpiSwiglu, pg8::MoeOrder<8>, true, true>(F.lds, g, S, E, F.tid); }); SEAM(p + 7);
        SITE(p + 8,
            { FRESH(); build_tab(F, l);
            pg8::Gemm g{(const bf16*)(F.ws + WS_ACT), (const bf16*)(F.ws + WS_W2 + (size_t)l * NE * D * FF), FF / 2};
            pg8::MoeOrder<4, true> S; S.init((const LAS int*)(F.lds + TAB_OFF), (const int*)(F.ws + WS_ROWTOK), F.G, F.bid, FF);
            pg8::EpiY E{F.ws + WS_Y, args.in[I_B2] + (size_t)l * NE * D};
            pg8::gemm_phase<pg8::EpiY, pg8::MoeOrder<4, true>, true, true>(F.lds, g, S, E, F.tid); }); SEAM(p + 8);
    }
    SITE(19, FRESH(); norm_phase<2>(F, args, 1););
#undef IN
#undef SEAM
}

extern "C" void kernel_launch(void* const* d_in, const int* in_sizes, int n_in, void* d_out, int out_size, void* d_ws, size_t ws_size, hipStream_t stream) {
    static int grid = 0;
    if (grid == 0) {
        if (n_in != N_IN || in_sizes[0] != M * D || out_size != M * D || ws_size < WS_END) { fprintf(stderr, "kernel_launch: unexpected shapes (n_in %d, in0 %d, out %d, ws %zu)\n", n_in, n_in > 0 ? in_sizes[0] : -1, out_size, ws_size); grid = -1; return; }
        int dev = 0, cus = 0, per_cu = 0;
        if (hipGetDevice(&dev) != hipSuccess || hipDeviceGetAttribute(&cus, hipDeviceAttributeMultiprocessorCount, dev) != hipSuccess) { grid = -1; return; }
        if (hipFuncSetAttribute((const void*)mk_fwd, hipFuncAttributeMaxDynamicSharedMemorySize, LDS_BYTES) != hipSuccess) { fprintf(stderr, "kernel_launch: hipFuncSetAttribute failed\n"); grid = -1; return; }
        if (hipOccupancyMaxActiveBlocksPerMultiprocessor(&per_cu, (const void*)mk_fwd, 512, LDS_BYTES) != hipSuccess || per_cu < 1) fprintf(stderr, "kernel_launch: occupancy query says %d\n", per_cu);
        (void)hipGetLastError();
        grid = cus;
    }
    if (grid < 0) return;
    (void)hipMemsetAsync((char*)d_ws + WS_CTL, 0, CTL_ZERO_BYTES, stream);
    Args a{};
    for (int i = 0; i < N_IN; ++i) a.in[i] = (const float*)d_in[i];
    a.out = (float*)d_out; a.ws = (unsigned char*)d_ws;
#if MK_N_LAUNCHES == 1
    a.ph_lo = 0; a.ph_hi = NPH;
    hipLaunchKernelGGL(mk_fwd, dim3(grid), dim3(512), LDS_BYTES, stream, a);
#else
    for (int ph = 0; ph < NPH; ++ph) { a.ph_lo = ph; a.ph_hi = ph + 1; hipLaunchKernelGGL(mk_fwd, dim3(grid), dim3(512), LDS_BYTES, stream, a); }
#endif
}
```

```cpp
#include <hip/hip_runtime.h>
#include <cstdio>
#include <cstdint>

#ifndef MK_N_LAUNCHES
#define MK_N_LAUNCHES 1
#endif

#define NOPK __attribute__((target("no-packed-fp32-ops")))
#define __uint_as_float(x) __builtin_bit_cast(float, (unsigned)(x))
#define __float_as_uint(x) __builtin_bit_cast(unsigned, (float)(x))
#define __float_as_int(x) __builtin_bit_cast(int, (float)(x))
#define __int_as_float(x) __builtin_bit_cast(float, (int)(x))
#define __syncthreads() do { __builtin_amdgcn_fence(__ATOMIC_RELEASE, "workgroup"); __builtin_amdgcn_s_barrier(); __builtin_amdgcn_fence(__ATOMIC_ACQUIRE, "workgroup"); } while (0)
#define __all(p) (__builtin_amdgcn_ballot_w64(!(p)) == 0ull)
#define atomicAdd(p, v) __hip_atomic_fetch_add((p), (v), __ATOMIC_RELAXED, __HIP_MEMORY_SCOPE_AGENT)
#define __shfl_xor(v, m) shfl_xor_f32((v), (m))
#define GAS __attribute__((address_space(1)))
#define LAS __attribute__((address_space(3)))
typedef unsigned short bf16;
typedef short bf16x8 __attribute__((ext_vector_type(8)));
typedef float f32x2 __attribute__((ext_vector_type(2)));
typedef float f32x4 __attribute__((ext_vector_type(4)));
typedef float f32x16 __attribute__((ext_vector_type(16)));
typedef unsigned u32x2 __attribute__((ext_vector_type(2)));
typedef unsigned u32x4 __attribute__((ext_vector_type(4)));
typedef int i32x4 __attribute__((ext_vector_type(4)));
typedef int i32x8 __attribute__((ext_vector_type(8)));
typedef short s16x4 __attribute__((ext_vector_type(4)));

constexpr int D = 1024, BATCH = 32, SEQ = 2048, M = BATCH * SEQ, DEPTH = 2;
constexpr int HD = 64, DR = 512, NH = 8;
constexpr int C_RWKV = 1792, C_IN = 3328;
constexpr int NE = 32, FF = 1024;
constexpr int ECAP = 65536;
constexpr int NROWS_MAX = M * 4 + NE * 256;
constexpr int NPH = 20;
constexpr float NORM_EPS = 1e-6f, GN_EPS = 1e-5f * 64.f;
constexpr float SB_EXIT = -30.f;

enum { I_X = 0, I_C, I_N1G, I_N2G, I_ADAW, I_ADAB, I_WIN, I_MU, I_DW0, I_DUP, I_IA0, I_IUP, I_GUP, I_KK, I_KA, I_RK, I_LNW, I_LNB, I_VRD, I_VRU, I_VRB,
       I_QG, I_KG, I_SBG, I_WOUT, I_RW, I_RB, I_W1, I_B1, I_W2, I_B2, N_IN };

constexpr size_t MiB = 1u << 20;
constexpr size_t WS_CTL = 0, CTL_ZERO_BYTES = 1 * MiB;
constexpr size_t WS_MOD = 1 * MiB;
constexpr size_t WS_LORA = 3 * MiB;
constexpr size_t LORA_STRIDE = 512 * 1024;
constexpr size_t LO_DUP = 0, LO_IUP = 65536, LO_GUP = 131072, LO_VRD = 262144, LO_VRU = 294912, LO_RWS = 327680;
constexpr size_t WS_WOUT = 4 * MiB;
constexpr size_t WS_WIN = 8 * MiB;
constexpr size_t WS_W1 = 22 * MiB;
constexpr size_t WS_W2 = 278 * MiB;
constexpr size_t WS_VFIRST = 406 * MiB;
constexpr size_t WS_ROWTOK = 470 * MiB;
constexpr size_t WS_TOKSLOT = 478 * MiB;
constexpr size_t WS_TOKGATE = 479 * MiB;
constexpr size_t WS_BON = WS_TOKSLOT;
constexpr size_t WS_H = 480 * MiB;
constexpr size_t WS_T = 608 * MiB;
constexpr size_t WS_Z = WS_T;
constexpr size_t WS_OPS = WS_T + 416 * MiB;
constexpr size_t WS_QN = WS_T + 864 * MiB;
constexpr size_t WS_KN = WS_T + 928 * MiB;
constexpr size_t WS_VF = WS_T + 992 * MiB;
constexpr size_t WS_YCAT = WS_T + 1056 * MiB;
constexpr size_t WS_ACT = WS_T;
constexpr size_t WS_Y = WS_T + 528 * MiB;
constexpr size_t WS_X1 = WS_T + 272 * MiB;
constexpr size_t WS_END = WS_T + 1184 * MiB;
static_assert((size_t)NROWS_MAX * 2048 <= 528 * MiB, "act/y buffers");
static_assert((size_t)NROWS_MAX * 1024 <= 272 * MiB, "e4m3 act rows end below x1");
constexpr int CW_TMO = 0, CW_BAR = 4096, CW_CNT = 16384;

constexpr int RING_BYTES = 131072;
constexpr int XTRA_OFF = RING_BYTES, XTRA_BYTES = 32512;
constexpr int MISC_OFF = XTRA_OFF + XTRA_BYTES;
constexpr int LDS_BYTES = MISC_OFF + 256;
constexpr int TAB_OFF = XTRA_OFF;
constexpr int GOFF_OFF = XTRA_OFF + 4096;

__device__ __forceinline__ NOPK float shfl_xor_f32(float v, int m) { int lane = (int)__builtin_amdgcn_mbcnt_hi(~0u, __builtin_amdgcn_mbcnt_lo(~0u, 0u)); asm volatile("" : "+v"(lane));     return __builtin_bit_cast(float, __builtin_amdgcn_ds_bpermute((lane ^ m) << 2, __builtin_bit_cast(int, v))); }
typedef __bf16 bf16v2_t __attribute__((ext_vector_type(2)));
__device__ __forceinline__ NOPK unsigned cvt_pk_bf16(float lo, float hi) { const f32x2 v = {lo, hi}; return __builtin_bit_cast(unsigned, __builtin_convertvector(v, bf16v2_t)); }
__device__ __forceinline__ NOPK float bflo(unsigned w) { return __uint_as_float(w << 16); }
__device__ __forceinline__ NOPK float bfhi(unsigned w) { return __uint_as_float(w & 0xffff0000u); }
__device__ __forceinline__ NOPK float wave_sum(float v) {
#pragma unroll
    for (int o = 1; o < 64; o <<= 1) v += __shfl_xor(v, o);
    return v;
}
template <int CTRL> __device__ __forceinline__ NOPK float dpp_add(float x) { return x + __int_as_float(__builtin_amdgcn_update_dpp(0, __float_as_int(x), CTRL, 0xf, 0xf, true)); }
__device__ __forceinline__ NOPK float red4(float x) { x = dpp_add<0xB1>(x); x = dpp_add<0x4E>(x); return x; }
__device__ __forceinline__ NOPK float red8(float x) { x = red4(x); return dpp_add<0x141>(x); }
__device__ __forceinline__ NOPK float red16(float x) { x = red8(x); return dpp_add<0x140>(x); }
__device__ __forceinline__ NOPK float fsigmoid(float x) { return __builtin_amdgcn_rcpf(1.0f + __builtin_amdgcn_exp2f(-1.44269504f * x)); }
__device__ __forceinline__ NOPK float ftanh(float x) { const float t = __builtin_amdgcn_exp2f(-2.88539008f * fabsf(x)); const float r = (1.0f - t) * __builtin_amdgcn_rcpf(1.0f + t); return x < 0.f ? -r : r; }
__device__ __forceinline__ NOPK float fsoftplus(float x) { return fmaxf(x, 0.f) + 0.69314718f * __builtin_amdgcn_logf(1.0f + __builtin_amdgcn_exp2f(-1.44269504f * fabsf(x))); }
__device__ __forceinline__ NOPK unsigned pk_fp8x4(float a, float b, float c, float d) { int w = 0; w = __builtin_amdgcn_cvt_pk_fp8_f32(a, b, w, false); w = __builtin_amdgcn_cvt_pk_fp8_f32(c, d, w, true); return (unsigned)w; }
constexpr float W8_SCALE = 64.0f; constexpr int W8_EXP = 127 - 3, A8_EXP = 127 - 3;
constexpr float Y8_SCALE = 16.0f;
#define LDS_WAIT() asm volatile("s_waitcnt lgkmcnt(0)" ::: "memory")
#define LDS_IADD(p, v) ((void)__hip_atomic_fetch_add((p), (v), __ATOMIC_RELAXED, __HIP_MEMORY_SCOPE_WORKGROUP))
#define LDS_BARRIER() do { asm volatile("s_waitcnt lgkmcnt(0)" ::: "memory"); __builtin_amdgcn_s_barrier(); asm volatile("" ::: "memory"); } while (0)
#define VM_WAIT() asm volatile("s_waitcnt vmcnt(0)" ::: "memory")

#define XB_TMO      128
#define XB_XCNT(j)  (256  + 64 * (j))
#define XB_XSUB(j)  (1280 + 64 * (j))
#define XB_XGEN(j)  (2304 + 64 * (j))
#define XB_TOP      3328
#define XB_TOPGEN   3392
#define XCD_BAR_WORDS 3456
#define XB_SPIN_CAP (1u << 18)
__device__ __forceinline__ NOPK unsigned xb_ld(unsigned* p)              { return __hip_atomic_load(p, __ATOMIC_RELAXED, __HIP_MEMORY_SCOPE_AGENT); }
__device__ __forceinline__ NOPK unsigned xb_add(unsigned* p, unsigned v) { return __hip_atomic_fetch_add(p, v, __ATOMIC_RELAXED, __HIP_MEMORY_SCOPE_AGENT); }
__device__ __forceinline__ NOPK unsigned xb_xcc_id() { return (unsigned)__builtin_amdgcn_s_getreg((3 << 11) | 20) & 0xFu; }
#define XB_SPIN(cond, bar) do { unsigned _sp = 0; while (cond) { __builtin_amdgcn_s_sleep(1); \
    if ((++_sp & 255u) == 0u) { if (xb_ld(&(bar)[XB_TMO])) break; if (_sp > XB_SPIN_CAP) { atomicAdd(&(bar)[XB_TMO], 1u); break; } } } } while (0)
struct XcdBarrier { unsigned* bar; unsigned x; volatile LAS unsigned* st; };
__device__ __forceinline__ NOPK XcdBarrier xcd_barrier_post(unsigned* bar, volatile LAS unsigned* st, int tid) {
    XcdBarrier b; b.bar = bar; b.x = xb_xcc_id(); b.st = st;
    if (tid == 0) (void)xb_add(&bar[XB_XCNT(b.x)], 1u);
    return b;
}
__device__ __forceinline__ NOPK void xcd_barrier_complete(unsigned* bar, unsigned x, unsigned& nloc, unsigned& nx) {
    const unsigned G = gridDim.x * gridDim.y * gridDim.z;
    unsigned sum, cnt, mine, sp = 0u;
    for (;;) {
        sum = 0u; cnt = 0u; mine = 0u;
#pragma unroll
        for (unsigned j = 0; j < 16; ++j) { const unsigned c = xb_ld(&bar[XB_XCNT(j)]); sum += c; cnt += (c > 0u) ? 1u : 0u; mine = (j == x) ? c : mine; }
        if (sum == G) break;
        __builtin_amdgcn_s_sleep(1);
        if ((++sp & 255u) == 0u) { if (xb_ld(&bar[XB_TMO])) break; if (sp > XB_SPIN_CAP) { atomicAdd(&bar[XB_TMO], 1u); break; } }
    }
    nloc = mine > 0u ? mine : 1u; nx = cnt > 0u ? cnt : 1u;
}
__device__ __forceinline__ NOPK void xcd_barrier(const XcdBarrier& b, int tid) {
    asm volatile("s_waitcnt vmcnt(0)" ::: "memory");
    __syncthreads();
    if (tid == 0) {
        unsigned* bar = b.bar;
        __builtin_amdgcn_s_waitcnt(0);
        unsigned nloc = b.st[0], nx = b.st[1];
        if (nloc == 0u) { xcd_barrier_complete(bar, b.x, nloc, nx); b.st[0] = nloc; b.st[1] = nx; }
        const unsigned old = xb_add(&bar[XB_XSUB(b.x)], 1u);
        const unsigned gen = old / nloc;
        if (old + 1u == (gen + 1u) * nloc) {
            __builtin_amdgcn_fence(__ATOMIC_RELEASE, "agent");
            asm volatile("s_waitcnt vmcnt(0)" ::: "memory");
            const unsigned og = xb_add(&bar[XB_TOP], 1u);
            const unsigned tg = og / nx;
            if (og + 1u == (tg + 1u) * nx) xb_add(&bar[XB_TOPGEN], 1u);
            else XB_SPIN(xb_ld(&bar[XB_TOPGEN]) == tg, bar);
            __builtin_amdgcn_fence(__ATOMIC_ACQUIRE, "agent");
            xb_add(&bar[XB_XGEN(b.x)], 1u);
            asm volatile("s_waitcnt vmcnt(0)" ::: "memory");
        } else {
            XB_SPIN(xb_ld(&bar[XB_XGEN(b.x)]) == gen, bar);
            __builtin_amdgcn_fence(__ATOMIC_ACQUIRE, "agent");
            asm volatile("s_waitcnt vmcnt(0)" ::: "memory");
        }
    }
    __syncthreads();
}

namespace pg8 {
constexpr int BM = 256, BK = 64, HALF = 128, HTB = HALF * BK * 2, STAGE_BYTES = 8 * HTB, NXCD = 8;
__host__ __device__ __forceinline__ NOPK int lds_byte(int r, int c) { const int st = (r >> 4) * 2 + (c >> 5), rr = r & 15, cc = c & 31, ob = rr * 64 + cc * 2; return st * 1024 + (ob ^ (((ob >> 9) & 1) << 5)); }
__host__ __device__ __forceinline__ NOPK void stage_rc(int b, int& R, int& C) { const int st = b / 1024, sb = b % 1024, swz = sb ^ (((sb >> 9) & 1) << 5); R = (st >> 1) * 16 + swz / 64; C = (st & 1) * 32 + (swz % 64) / 2; }
__host__ __device__ __forceinline__ NOPK int perm32(int rho) { const int n = rho >> 4, i = rho & 15; return 8 * (i >> 2) + 4 * n + (i & 3); }
__host__ __device__ __forceinline__ int perm64(int R) { const int wc = (R >> 5) & 3, rho = R & 31, n = rho >> 4, fq = (rho & 15) >> 2, e = rho & 3; return 64 * wc + 8 * fq + 4 * n + e; }
__host__ __device__ __forceinline__ int perm256(int R) { const int wc = (R >> 5) & 3, rho = R & 31, n = rho >> 4, fq = (rho & 15) >> 2, e = rho & 3; return 64 * wc + 16 * fq + 4 * n + e; }
struct Unit { int pm, pn, e; };
struct Gemm { const bf16* A; const bf16* Bt; int K; };

template <int WGM> struct StaticOrder {
    int nM, nN, nwg, G, c;
    __device__ __forceinline__ NOPK void init(int M_, int N_, int G_, int c_) { nM = M_ / BM; nN = N_ / BM; nwg = nM * nN; G = G_; c = c_; }
    __device__ __forceinline__ NOPK bool next(int i, Unit& u) const {
        const long L = (long)i * G + c; if (L >= nwg) return false;
        int wgid = (int)L; { const int q = nwg / NXCD, r = nwg % NXCD, xcd = wgid % NXCD, off = wgid / NXCD; wgid = (xcd < r ? xcd * (q + 1) : r * (q + 1) + (xcd - r) * q) + off; }
        const int nig = WGM * nN, gid = wgid / nig, fm = gid * WGM, gsz = (nM - fm) < WGM ? (nM - fm) : WGM;
        u.pm = fm + ((wgid % nig) % gsz); u.pn = (wgid % nig) / gsz; u.e = 0; return true;
    }
    __device__ __forceinline__ NOPK unsigned row_off(const Unit&, int) const { return 0u; }
};
template <int NPN, bool IDENT = false> struct MoeOrder {
    const LAS int* tab;
    const int* rowtok;
    int G, c, T, K2;
    __device__ __forceinline__ NOPK void init(const LAS int* tab_, const int* rowtok_, int G_, int c_, int K2_) { tab = tab_; rowtok = rowtok_; G = G_; c = c_; T = tab_[32]; K2 = K2_; }
    __device__ __forceinline__ NOPK bool next(int i, Unit& u) const {
        constexpr int TPR = 256 / NPN, TPX = TPR / 8;
        int tile, pnl;
        if (G == 256) { const int r = c >> 3; tile = i * TPR + (c & 7) * TPX + r / NPN; pnl = r % NPN; }
        else { const long L = (long)i * G + c; tile = (int)(L / NPN); pnl = (int)(L % NPN); }
        if (tile >= T) return false;
        const int lo = ((const LAS unsigned char*)tab)[1024 + tile];
        u.pm = tile; u.e = lo; u.pn = lo * NPN + pnl; return true;
    }
    __device__ __forceinline__ NOPK unsigned row_off(const Unit& u, int r) const {
        if constexpr (IDENT) return (unsigned)(u.pm * 256 + r) * (unsigned)K2;
        const int slot = (u.pm - tab[u.e]) * 256 + r; const int cnt = tab[64 + u.e];
        const int tok = slot < cnt ? rowtok[u.e * ECAP + slot] : 0;
        return (unsigned)tok * (unsigned)K2;
    }
};

template <class Epi, class Sched, bool GATHER, bool FP8 = false>
__device__ __forceinline__ NOPK void gemm_phase(LAS unsigned char* lds, const Gemm g, const Sched& S, const Epi& E, int tid_in) {
    int tid_ = tid_in; asm volatile("" : "+v"(tid_));
    const int tid = tid_, wid = __builtin_amdgcn_readfirstlane(tid >> 6), lane = tid & 63, wr = wid >> 2, wc = wid & 3, fr = lane & 15, fq = lane >> 4;
    int K_ = g.K; asm volatile("" : "+s"(K_));
    const int K = K_, nt = K / BK;
    unsigned voffA[2], voffB[2]; int RA[2];
#pragma unroll
    for (int i = 0; i < 2; ++i) { int R, C; stage_rc(tid * 16 + i * 8192, R, C); const int Rb = Epi::PERM == 2 ? perm256(R) : (Epi::PERM == 3 ? perm64(R) : (Epi::PERM ? ((R & ~31) + perm32(R & 31)) : R));
        RA[i] = R; voffA[i] = GATHER ? 0u : (unsigned)(R * K + C) * 2u; voffB[i] = (unsigned)(Rb * K + C) * 2u; }
    const unsigned kstep = (unsigned)(BK * 2);
    const unsigned hstep = (unsigned)HALF * (unsigned)K * 2u;
    const unsigned tstep = 2u * hstep;
    const unsigned hstepB = (Epi::PERM == 2) ? 8u * (unsigned)K * 2u : ((Epi::PERM == 3) ? 32u * (unsigned)K * 2u : hstep);
    const unsigned ldsw = (unsigned)wid * 1024u;
    const int aoff = lds_byte(wr * 64 + fr, fq * 8), boff = lds_byte(wc * 32 + fr, fq * 8);
    const __amdgpu_buffer_rsrc_t rA = __builtin_amdgcn_make_buffer_rsrc((void*)g.A, (short)0, (int)0xffffffffu, 0x00020000);
    const __amdgpu_buffer_rsrc_t rB = __builtin_amdgcn_make_buffer_rsrc((void*)g.Bt, (short)0, (int)0xffffffffu, 0x00020000);
#define PG8_SA(b, h) (((b) * 2 + (h)) * HTB)
#define PG8_SB(b, h) ((4 + (b) * 2 + (h)) * HTB)
#define PG8_STG(rs, bufoff, soff, voff) do { _Pragma("unroll") for (int _i = 0; _i < 2; ++_i) \
        __builtin_amdgcn_raw_ptr_buffer_load_lds(rs, (LAS unsigned*)(lds + (bufoff) + ldsw + _i * 8192), 16, (int)(voff)[_i], (int)(soff), 0, 0); } while (0)
#define PG8_STAGE_B(bufoff, soff) PG8_STG(rB, bufoff, soff, voffB)
#define PG8_STAGE_A(bufoff, h, kb) do { if constexpr (GATHER) { PG8_STG(rA, bufoff, kb, gA[h]); } else { PG8_STG(rA, bufoff, oA + (unsigned)(h) * hstep + (kb), voffA); } } while (0)
#define PG8_LDA(dst, b, h) do { _Pragma("unroll") for (int m = 0; m < 4; ++m) _Pragma("unroll") for (int k = 0; k < 2; ++k) dst[m][k] = *(const LAS bf16x8*)(lds + PG8_SA(b, h) + aoff + m * 2048 + k * 1024); } while (0)
#define PG8_LDB(dst, b, h) do { _Pragma("unroll") for (int n = 0; n < 2; ++n) _Pragma("unroll") for (int k = 0; k < 2; ++k) dst[n][k] = *(const LAS bf16x8*)(lds + PG8_SB(b, h) + boff + n * 2048 + k * 1024); } while (0)
#define PG8_CAT(x, y) __builtin_shufflevector(__builtin_bit_cast(i32x4, x), __builtin_bit_cast(i32x4, y), 0, 1, 2, 3, 4, 5, 6, 7)
#define PG8_MMA(ai, bj, At, Bt) do { __builtin_amdgcn_s_setprio(1); _Pragma("unroll") for (int m = 0; m < 4; ++m) _Pragma("unroll") for (int n = 0; n < 2; ++n) { \
        if constexpr (FP8) acc[ai][bj][m][n] = __builtin_amdgcn_mfma_scale_f32_16x16x128_f8f6f4(PG8_CAT(Bt[n][0], Bt[n][1]), PG8_CAT(At[m][0], At[m][1]), acc[ai][bj][m][n], 0, 0, 0, (Epi::PERM == 2 ? W8_EXP + 2 : W8_EXP), 0, (Epi::PERM == 2 ? A8_EXP + 2 : A8_EXP)); \
        else { _Pragma("unroll") for (int k = 0; k < 2; ++k) acc[ai][bj][m][n] = __builtin_amdgcn_mfma_f32_16x16x32_bf16(Bt[n][k], At[m][k], acc[ai][bj][m][n], 0, 0, 0); } } __builtin_amdgcn_s_setprio(0); } while (0)
#define PG8_WAIT_V(n) asm volatile("s_waitcnt vmcnt(" #n ")" ::: "memory")
#define PG8_WAIT_V8E() do { if (firstk) { if constexpr (Epi::NS == 8) asm volatile("s_waitcnt vmcnt(16)" ::: "memory"); else if constexpr (Epi::NS == 16) asm volatile("s_waitcnt vmcnt(24)" ::: "memory"); \
        else asm volatile("s_waitcnt vmcnt(40)" ::: "memory"); } else asm volatile("s_waitcnt vmcnt(8)" ::: "memory"); } while (0)
#define PG8_WAIT_L(n) asm volatile("s_waitcnt lgkmcnt(" #n ")" ::: "memory")
#define PG8_BAR __builtin_amdgcn_s_barrier()
#define PG8_SCHED __builtin_amdgcn_sched_barrier(0)
    Unit cur, nxt; int ui = 0;
    if (!S.next(0, cur)) return;
    f32x4 acc[2][2][4][2];
    { float z_ = 0.f; asm volatile("" : "+v"(z_));
#pragma unroll
    for (int a = 0; a < 2; ++a)
#pragma unroll
        for (int b = 0; b < 2; ++b)
#pragma unroll
            for (int m = 0; m < 4; ++m)
#pragma unroll
                for (int n = 0; n < 2; ++n) acc[a][b][m][n] = (f32x4){z_, z_, z_, z_}; }
    bf16x8 At[4][2], B0[2][2], B1[2][2];
    unsigned oA = GATHER ? 0u : (unsigned)cur.pm * tstep, oB = (unsigned)cur.pn * tstep;
    unsigned gA[2][2];
    if constexpr (GATHER) {
#pragma unroll
        for (int h = 0; h < 2; ++h)
#pragma unroll
            for (int i = 0; i < 2; ++i) { int R_, C_; stage_rc(tid * 16 + i * 8192, R_, C_); gA[h][i] = S.row_off(cur, h * HALF + R_) + (unsigned)(C_ * 2); }
    } else { gA[0][0] = gA[0][1] = gA[1][0] = gA[1][1] = 0u; }
    PG8_STAGE_B(PG8_SB(0, 0), oB); PG8_STAGE_B(PG8_SB(0, 1), oB + hstepB); PG8_STAGE_A(PG8_SA(0, 0), 0, 0u); PG8_STAGE_A(PG8_SA(0, 1), 1, 0u);
    if (wr == 1) PG8_BAR;
    PG8_WAIT_V(2); PG8_BAR;
    PG8_STAGE_B(PG8_SB(1, 0), oB + kstep); PG8_STAGE_A(PG8_SA(1, 0), 0, kstep); PG8_STAGE_B(PG8_SB(1, 1), oB + hstepB + kstep);
    PG8_WAIT_V(6); PG8_BAR;
    for (;;) {
        const bool has_next = S.next(ui + 1, nxt);
        const unsigned noA = (has_next && !GATHER) ? (unsigned)nxt.pm * tstep : oA, noB = has_next ? (unsigned)nxt.pn * tstep : oB;
#pragma nounroll
        for (int t = 0; t < nt; t += 2) {
            const bool last = (t == nt - 2), firstk = (t == 0) && (ui > 0);
            const unsigned b2 = last ? noB : oB + (unsigned)(t + 2) * kstep, b3 = b2 + kstep;
            const unsigned k2 = last ? 0u : (unsigned)(t + 2) * kstep;
            unsigned nA_[2][2];
            if constexpr (GATHER) {
                if (t == 0 && has_next) {
                    int tq_ = (int)__builtin_amdgcn_mbcnt_hi(~0u, __builtin_amdgcn_mbcnt_lo(~0u, 0u)); asm volatile("" : "+v"(tq_)); tq_ += wid * 64;
                    u32x4 pk_;
#pragma unroll
                    for (int h = 0; h < 2; ++h)
#pragma unroll
                        for (int i = 0; i < 2; ++i) { int R_, C_; stage_rc(tq_ * 16 + i * 8192, R_, C_); pk_[h * 2 + i] = S.row_off(nxt, h * HALF + R_) + (unsigned)(C_ * 2); }
                    *(LAS u32x4*)(lds + GOFF_OFF + tq_ * 16) = pk_; }
                if (last && has_next) {
                    int tq_ = (int)__builtin_amdgcn_mbcnt_hi(~0u, __builtin_amdgcn_mbcnt_lo(~0u, 0u)); asm volatile("" : "+v"(tq_)); tq_ += wid * 64;
                    const u32x4 pk_ = *(const LAS u32x4*)(lds + GOFF_OFF + tq_ * 16);
                    nA_[0][0] = pk_.x; nA_[0][1] = pk_.y; nA_[1][0] = pk_.z; nA_[1][1] = pk_.w; } }
            PG8_LDB(B0, 0, 0); PG8_LDB(B1, 0, 1); PG8_SCHED; PG8_LDA(At, 0, 0); PG8_STAGE_A(PG8_SA(1, 1), 1, (unsigned)(t + 1) * kstep);
            if (last) { if constexpr (GATHER) { if (has_next) {
#pragma unroll
                for (int h = 0; h < 2; ++h)
#pragma unroll
                    for (int i = 0; i < 2; ++i) gA[h][i] = nA_[h][i]; } } else { oA = noA; } }
            PG8_WAIT_V8E(); PG8_WAIT_L(0); PG8_BAR; PG8_MMA(0, 0, At, B0); PG8_MMA(0, 1, At, B1); PG8_BAR; PG8_SCHED;
            PG8_LDA(At, 0, 1); PG8_STAGE_B(PG8_SB(0, 0), b2); PG8_STAGE_B(PG8_SB(0, 1), b2 + hstepB); PG8_STAGE_A(PG8_SA(0, 0), 0, k2);
            PG8_WAIT_V8E(); PG8_WAIT_L(0); PG8_BAR; PG8_MMA(1, 0, At, B0); PG8_MMA(1, 1, At, B1); PG8_BAR; PG8_SCHED;
            PG8_LDB(B0, 1, 0); PG8_LDB(B1, 1, 1); PG8_SCHED; PG8_LDA(At, 1, 0); PG8_STAGE_A(PG8_SA(0, 1), 1, k2);
            PG8_WAIT_V(8); PG8_WAIT_L(0); PG8_BAR; PG8_MMA(0, 0, At, B0); PG8_MMA(0, 1, At, B1); PG8_BAR; PG8_SCHED;
            PG8_LDA(At, 1, 1); PG8_STAGE_B(PG8_SB(1, 0), b3); PG8_STAGE_B(PG8_SB(1, 1), b3 + hstepB); PG8_STAGE_A(PG8_SA(1, 0), 0, k2 + kstep);
            PG8_WAIT_V(8); PG8_WAIT_L(0); PG8_BAR; PG8_MMA(1, 0, At, B0); PG8_MMA(1, 1, At, B1); PG8_BAR; PG8_SCHED;
        }
        if (wr == 0) PG8_BAR;
        { int ln_ = (int)__builtin_amdgcn_mbcnt_hi(~0u, __builtin_amdgcn_mbcnt_lo(~0u, 0u)); asm volatile("" : "+v"(ln_));
          E(acc, cur, wr, wc, ln_ & 15, ln_ >> 4); }
        if (!has_next) break;
        { float z_ = 0.f; asm volatile("" : "+v"(z_));
#pragma unroll
        for (int a = 0; a < 2; ++a)
#pragma unroll
            for (int b = 0; b < 2; ++b)
#pragma unroll
                for (int m = 0; m < 4; ++m)
#pragma unroll
                    for (int n = 0; n < 2; ++n) acc[a][b][m][n] = (f32x4){z_, z_, z_, z_}; }
        cur = nxt; oB = noB; ++ui;
        if (wr == 1) PG8_BAR;
    }
    PG8_WAIT_V(0);
    PG8_BAR;
#undef PG8_SA
#undef PG8_SB
#undef PG8_STG
#undef PG8_STAGE_B
#undef PG8_STAGE_A
#undef PG8_LDA
#undef PG8_LDB
#undef PG8_MMA
#undef PG8_CAT
#undef PG8_WAIT_V
#undef PG8_WAIT_V8E
#undef PG8_WAIT_L
#undef PG8_BAR
#undef PG8_SCHED
}

struct EpiBf16 {
    static constexpr int PERM = 3; static constexpr int NS = 16;
    bf16* O; int ldc;
    __device__ __forceinline__ NOPK void operator()(const f32x4 (&acc)[2][2][4][2], const Unit& u, int wr, int wc, int fr, int fq) const {
        const int row0 = u.pm * BM + wr * 64 + fr, col0 = u.pn * BM + wc * 64 + 8 * fq;
#pragma unroll
        for (int ai = 0; ai < 2; ++ai)
#pragma unroll
            for (int m = 0; m < 4; ++m) { bf16* rowp = O + (size_t)(row0 + ai * HALF + m * 16) * ldc + col0;
#pragma unroll
                for (int bj = 0; bj < 2; ++bj) { const f32x4 v0 = acc[ai][bj][m][0], v1 = acc[ai][bj][m][1];
                    u32x4 w; w.x = cvt_pk_bf16(v0[0], v0[1]); w.y = cvt_pk_bf16(v0[2], v0[3]); w.z = cvt_pk_bf16(v1[0], v1[1]); w.w = cvt_pk_bf16(v1[2], v1[3]);
                    *(u32x4*)(rowp + bj * 32) = w; } }
    }
};
struct EpiResid {
    static constexpr bool PERM = true; static constexpr int NS = 16;
    const float* base; bf16* out; const float* gate;
    __device__ __forceinline__ NOPK void operator()(const f32x4 (&acc)[2][2][4][2], const Unit& u, int wr, int wc, int fr, int fq) const {
        const int row0 = u.pm * BM + wr * 64 + fr, col0 = u.pn * BM + wc * 32 + 8 * fq; const int b = (u.pm * BM) / SEQ;
        f32x4 gv[2][2];
#pragma unroll
        for (int bj = 0; bj < 2; ++bj)
#pragma unroll
            for (int n = 0; n < 2; ++n) gv[bj][n] = *(const f32x4*)(gate + (size_t)b * 6144 + col0 + bj * HALF + 4 * n);
#pragma unroll
        for (int ai = 0; ai < 2; ++ai)
#pragma unroll
            for (int m = 0; m < 4; ++m) { const size_t off = (size_t)(row0 + ai * HALF + m * 16) * D + col0;
#pragma unroll
                for (int bj = 0; bj < 2; ++bj) { const f32x4 b0 = *(const f32x4*)(base + off + bj * HALF), b1 = *(const f32x4*)(base + off + bj * HALF + 4);
                    const f32x4 o0 = b0 + gv[bj][0] * acc[ai][bj][m][0], o1 = b1 + gv[bj][1] * acc[ai][bj][m][1];
                    u32x4 w; w.x = cvt_pk_bf16(o0[0], o0[1]); w.y = cvt_pk_bf16(o0[2], o0[3]); w.z = cvt_pk_bf16(o1[0], o1[1]); w.w = cvt_pk_bf16(o1[2], o1[3]);
                    *(u32x4*)(out + off + bj * HALF) = w; } }
    }
};
struct EpiSwiglu {
    static constexpr bool PERM = true; static constexpr int NS = 8;
    unsigned char* O; const float* b1;
    __device__ __forceinline__ NOPK void operator()(const f32x4 (&acc)[2][2][4][2], const Unit& u, int wr, int wc, int fr, int fq) const {
        const int pnl = u.pn - u.e * 8; const int row0 = u.pm * BM + wr * 64 + fr, cg = pnl * 128 + wc * 32 + 8 * fq;
        const float* bp = b1 + (size_t)u.e * 2048 + cg;
        const f32x4 bg0 = *(const f32x4*)(bp), bg1 = *(const f32x4*)(bp + 4), bl0 = *(const f32x4*)(bp + 1024), bl1 = *(const f32x4*)(bp + 1028);
#pragma unroll
        for (int ai = 0; ai < 2; ++ai)
#pragma unroll
            for (int m = 0; m < 4; ++m) { unsigned char* rowp = O + (size_t)(row0 + ai * HALF + m * 16) * FF + cg;
                f32x4 o[2];
#pragma unroll
                for (int n = 0; n < 2; ++n) { const f32x4 gl = acc[ai][0][m][n] + (n ? bg1 : bg0), li = acc[ai][1][m][n] + (n ? bl1 : bl0);
#pragma unroll
                    for (int j = 0; j < 4; ++j) { const float gq = fminf(gl[j], 7.0f), lq = __builtin_amdgcn_fmed3f(li[j], -7.0f, 7.0f);
                        o[n][j] = gq * __builtin_amdgcn_rcpf(1.0f + __builtin_amdgcn_exp2f(-2.4554669f * gq)) * (lq + 1.0f); } }
                u32x2 w; w.x = pk_fp8x4(o[0][0], o[0][1], o[0][2], o[0][3]); w.y = pk_fp8x4(o[1][0], o[1][1], o[1][2], o[1][3]);
                *(u32x2*)rowp = w; }
    }
};
struct EpiY {
    static constexpr int PERM = 2; static constexpr int NS = 8;
    unsigned char* O; const float* b2;
    __device__ __forceinline__ NOPK void operator()(const f32x4 (&acc)[2][2][4][2], const Unit& u, int wr, int wc, int fr, int fq) const {
        const int pnl = u.pn - u.e * 4; const int row0 = u.pm * BM + wr * 64 + fr, col0 = pnl * BM + wc * 64 + 16 * fq;
        f32x4 bv[2][2];
#pragma unroll
        for (int bj = 0; bj < 2; ++bj)
#pragma unroll
            for (int n = 0; n < 2; ++n) bv[bj][n] = *(const f32x4*)(b2 + (size_t)u.e * D + col0 + 8 * bj + 4 * n) * Y8_SCALE;
#define Y8C(x) __builtin_amdgcn_fmed3f((x), -448.f, 448.f)
#pragma unroll
        for (int ai = 0; ai < 2; ++ai)
#pragma unroll
            for (int m = 0; m < 4; ++m) { unsigned char* rowp = O + (size_t)(row0 + ai * HALF + m * 16) * D + col0;
                u32x4 w;
#pragma unroll
                for (int bj = 0; bj < 2; ++bj) { const f32x4 v0 = acc[ai][bj][m][0] + bv[bj][0], v1 = acc[ai][bj][m][1] + bv[bj][1];
                    w[2 * bj] = pk_fp8x4(Y8C(v0[0]), Y8C(v0[1]), Y8C(v0[2]), Y8C(v0[3])); w[2 * bj + 1] = pk_fp8x4(Y8C(v1[0]), Y8C(v1[1]), Y8C(v1[2]), Y8C(v1[3])); }
                *(u32x4*)rowp = w; }
#undef Y8C
    }
};
}

struct Frame {
    LAS unsigned char* lds;
    int tid, lane, wave, G, bid;
    float* out; unsigned char* ws;
};
struct Args { const float* in[N_IN]; float* out; unsigned char* ws; int ph_lo, ph_hi; };

__device__ __forceinline__ NOPK void build_tab(Frame& F, int l) {
    LAS int* tab = (LAS int*)(F.lds + TAB_OFF);
    const unsigned* cnt = (const unsigned*)(F.ws + WS_CTL) + CW_CNT + 64 * l;
    if (F.tid < 32) tab[64 + F.tid] = (int)__hip_atomic_load(cnt + F.tid, __ATOMIC_RELAXED, __HIP_MEMORY_SCOPE_AGENT);
    __syncthreads();
    if (F.tid == 0) { int s = 0; for (int e = 0; e < 32; ++e) { tab[e] = s; s += (tab[64 + e] + 255) >> 8; } tab[32] = s; }
    __syncthreads();
    { LAS unsigned char* texp = (LAS unsigned char*)(F.lds + TAB_OFF + 1024); const int T = tab[32];
      for (int i = F.tid; i < T; i += 512) { int lo = 0, hi = 31; while (lo < hi) { const int mid = (lo + hi + 1) >> 1; if (tab[mid] <= i) lo = mid; else hi = mid - 1; } texp[i] = (unsigned char)lo; } }
    __syncthreads();
}

__device__ __forceinline__ NOPK void transpose_item(const float* W, int ldn, int k0, int n0, bf16* WT, int Kd, int drow0, int kvalid, LAS float* scr, int lane) {
#pragma unroll
    for (int i = 0; i < 8; ++i) { const int kk = 8 * i + (lane >> 3), nq = 4 * (lane & 7);
        const f32x4 v = kk < kvalid ? *(const f32x4*)(W + (size_t)(k0 + kk) * ldn + n0 + nq) : (f32x4){0.f, 0.f, 0.f, 0.f};
        scr[kk * 33 + nq] = v.x; scr[kk * 33 + nq + 1] = v.y; scr[kk * 33 + nq + 2] = v.z; scr[kk * 33 + nq + 3] = v.w; }
    LDS_WAIT(); asm volatile("" ::: "memory");
    const int c = lane & 7;
    if (8 * c < kvalid) {
#pragma unroll
        for (int j = 0; j < 4; ++j) { const int n = (lane >> 3) + 8 * j; const LAS float* s = scr + (8 * c) * 33 + n;
            u32x4 o; o.x = cvt_pk_bf16(s[0 * 33], s[1 * 33]); o.y = cvt_pk_bf16(s[2 * 33], s[3 * 33]); o.z = cvt_pk_bf16(s[4 * 33], s[5 * 33]); o.w = cvt_pk_bf16(s[6 * 33], s[7 * 33]);
            *(u32x4*)(WT + (size_t)(drow0 + n) * Kd + k0 + 8 * c) = o; }
    }
    LDS_WAIT(); asm volatile("" ::: "memory");
}
__device__ __forceinline__ NOPK void transpose_item_fp8(const float* W, int ldn, int k0, int n0, unsigned char* WT, int Kd, int drow0, LAS float* scr, int lane) {
#pragma unroll
    for (int i = 0; i < 8; ++i) { const int kk = 8 * i + (lane >> 3), nq = 4 * (lane & 7);
        const f32x4 v = *(const f32x4*)(W + (size_t)(k0 + kk) * ldn + n0 + nq);
        scr[kk * 33 + nq] = v.x; scr[kk * 33 + nq + 1] = v.y; scr[kk * 33 + nq + 2] = v.z; scr[kk * 33 + nq + 3] = v.w; }
    LDS_WAIT(); asm volatile("" ::: "memory");
    const int pc = lane & 3;
#define Q8(i) fminf(fmaxf(sp[(i) * 33] * W8_SCALE, -448.f), 448.f)
#pragma unroll
    for (int s2 = 0; s2 < 2; ++s2) { const int n = 16 * s2 + (lane >> 2); const LAS float* sp = scr + (16 * pc) * 33 + n;
        u32x4 o; o.x = pk_fp8x4(Q8(0), Q8(1), Q8(2), Q8(3)); o.y = pk_fp8x4(Q8(4), Q8(5), Q8(6), Q8(7)); o.z = pk_fp8x4(Q8(8), Q8(9), Q8(10), Q8(11)); o.w = pk_fp8x4(Q8(12), Q8(13), Q8(14), Q8(15));
        *(u32x4*)(WT + (size_t)(drow0 + n) * Kd + k0 + 16 * pc) = o; }
#undef Q8
    LDS_WAIT(); asm volatile("" ::: "memory");
}
__device__ __forceinline__ NOPK void p0_prologue(Frame& F, const Args& A) {
    if (F.bid < 192) {
        LAS float* cond = (LAS float*)F.lds;
        for (int i = F.tid; i < 32 * 1024; i += 512) { const float v = A.in[I_C][i]; cond[i] = v / (1.0f + __expf(-v)); }
        __syncthreads();
        const int l = F.bid / 96, j0 = (F.bid % 96) * 64;
        const float* W = A.in[I_ADAW] + (size_t)l * D * 6144 + j0;
        const int cq = F.lane & 15, kr = F.lane >> 4, b0 = F.wave * 4;
        f32x4 acc[4];
#pragma unroll
        for (int i = 0; i < 4; ++i) acc[i] = (f32x4){0.f, 0.f, 0.f, 0.f};
#pragma unroll 8
        for (int kk = 0; kk < 256; ++kk) { const int k = 4 * kk + kr; const f32x4 w = *(const f32x4*)(W + (size_t)k * 6144 + 4 * cq);
#pragma unroll
            for (int i = 0; i < 4; ++i) acc[i] += w * cond[(b0 + i) * 1024 + k]; }
#pragma unroll
        for (int i = 0; i < 4; ++i)
#pragma unroll
            for (int j = 0; j < 4; ++j) { float v = acc[i][j]; v += __shfl_xor(v, 16); v += __shfl_xor(v, 32); acc[i][j] = v; }
        if (kr == 0) { const f32x4 bb = *(const f32x4*)(A.in[I_ADAB] + (size_t)l * 6144 + j0 + 4 * cq);
#pragma unroll
            for (int i = 0; i < 4; ++i) *(f32x4*)((float*)(F.ws + WS_MOD) + ((size_t)l * 32 + b0 + i) * 6144 + j0 + 4 * cq) = acc[i] + bb; }
        __syncthreads();
    }
    if (F.bid == F.G - 1) {
        for (int i = F.tid; i < 2 * D * NE; i += 512) { const int l = i >> 15, r = i & 32767, k = r >> 5, e = r & 31; const float w = A.in[I_RW][i];
            const unsigned hi = cvt_pk_bf16(w, 0.f) & 0xffffu; const float rem = w - __uint_as_float(hi << 16); const unsigned lo = cvt_pk_bf16(rem, 0.f) & 0xffffu;
            bf16* dst = (bf16*)(F.ws + WS_LORA + (size_t)l * LORA_STRIDE + LO_RWS); dst[e * D + k] = (bf16)hi; dst[NE * D + e * D + k] = (bf16)lo; }
    }
    LAS float* scr = (LAS float*)(F.lds + F.wave * 16384);
    const int gw = F.bid * 8 + F.wave, NGW = F.G * 8;
    constexpr int I_IN = 16 * 104, I_OUT = 16 * 32, I_E1 = 16 * 64, I_E2 = 16 * 32;
    constexpr int N_IN_ITEMS = 2 * I_IN, N_OUT_ITEMS = 2 * I_OUT, N_E1 = 64 * I_E1, N_E2 = 64 * I_E2, N_LORA = 2 * (16 + 16 + 32) + 8 + 16;
    constexpr int NITEMS = N_IN_ITEMS + N_OUT_ITEMS + N_E1 + N_E2 + N_LORA;
    for (int it = gw; it < NITEMS; it += NGW) {
        int r = it;
        if (r < N_E1) { const int m = r / I_E1, q = r % I_E1, kb = q / 64, nb = q % 64, n0 = 32 * nb, jj = n0 & 1023, hi = n0 >> 10;
            transpose_item_fp8(A.in[I_W1] + (size_t)m * D * 2048, 2048, 64 * kb, n0, F.ws + WS_W1 + (size_t)m * 2048 * D, D, (jj >> 7) * 256 + hi * 128 + (jj & 127), scr, F.lane); continue; } r -= N_E1;
        if (r < N_E2) { const int m = r / I_E2, q = r % I_E2, kb = q / 32, nb = q % 32;
            transpose_item_fp8(A.in[I_W2] + (size_t)m * FF * D, D, 64 * kb, 32 * nb, F.ws + WS_W2 + (size_t)m * D * FF, FF, 32 * nb, scr, F.lane); continue; } r -= N_E2;
        if (r < N_IN_ITEMS) { const int l = r / I_IN, q = r % I_IN, kb = q / 104, nb = q % 104;
            transpose_item(A.in[I_WIN] + (size_t)l * D * C_IN, C_IN, 64 * kb, 32 * nb, (bf16*)(F.ws + WS_WIN) + (size_t)l * C_IN * D, D, 32 * nb, 64, scr, F.lane); continue; } r -= N_IN_ITEMS;
        if (r < N_OUT_ITEMS) { const int l = r / I_OUT, q = r % I_OUT, kb = q / 32, nb = q % 32;
            transpose_item(A.in[I_WOUT] + (size_t)l * D * D, D, 64 * kb, 32 * nb, (bf16*)(F.ws + WS_WOUT) + (size_t)l * D * D, D, 32 * nb, 64, scr, F.lane); continue; } r -= N_OUT_ITEMS;
        if (r < 128) { const int l = r / 64, q = r % 64; unsigned char* lo = F.ws + WS_LORA + (size_t)l * LORA_STRIDE;
            if (q < 16) transpose_item(A.in[I_DUP] + (size_t)l * 64 * DR, DR, 0, 32 * q, (bf16*)(lo + LO_DUP), 64, 32 * q, 64, scr, F.lane);
            else if (q < 32) transpose_item(A.in[I_IUP] + (size_t)l * 64 * DR, DR, 0, 32 * (q - 16), (bf16*)(lo + LO_IUP), 64, 32 * (q - 16), 64, scr, F.lane);
            else { const int qq = q - 32, kb = qq / 16, nb = qq % 16; transpose_item(A.in[I_GUP] + (size_t)l * 128 * DR, DR, 64 * kb, 32 * nb, (bf16*)(lo + LO_GUP), 128, 32 * nb, 64, scr, F.lane); }
            continue; } r -= 128;
        { unsigned char* lo = F.ws + WS_LORA + (size_t)1 * LORA_STRIDE;
          if (r < 8) transpose_item(A.in[I_VRD], 32, 64 * r, 0, (bf16*)(lo + LO_VRD), DR, 0, 64, scr, F.lane);
          else transpose_item(A.in[I_VRU], DR, 0, 32 * (r - 8), (bf16*)(lo + LO_VRU), 32, 32 * (r - 8), 32, scr, F.lane); }
    }
}

template <int MODE> __device__ __forceinline__ NOPK void norm_phase(Frame& F, const Args& A, int l) {
    if (MODE != 0) build_tab(F, MODE == 1 ? 0 : 1);
    const LAS int* tab = (const LAS int*)(F.lds + TAB_OFF);
    const float* mod = (const float*)(F.ws + WS_MOD);
    const unsigned char* Y = F.ws + WS_Y;
    const unsigned* tokslot = (const unsigned*)(F.ws + WS_TOKSLOT); const float* tokgate = (const float*)(F.ws + WS_TOKGATE);
    bf16* H = (bf16*)(F.ws + WS_H);
    const int gw = F.bid * 8 + F.wave, NGW = F.G * 8, TPW = M / NGW;
    for (int t0 = gw * TPW; t0 < M; t0 += NGW * TPW) {
        const int b = t0 / SEQ;
        f32x4 g1[4], sc[4], sh[4], g2[4];
#pragma unroll
        for (int j = 0; j < 4; ++j) { const int col = 4 * (64 * j + F.lane);
            if (MODE != 2) { g1[j] = *(const f32x4*)(A.in[I_N1G] + (size_t)l * D + col); sh[j] = *(const f32x4*)(mod + ((size_t)l * 32 + b) * 6144 + col); sc[j] = *(const f32x4*)(mod + ((size_t)l * 32 + b) * 6144 + 1024 + col) + 1.0f; }
            if (MODE != 0) g2[j] = *(const f32x4*)(mod + ((size_t)(MODE == 1 ? 0 : 1) * 32 + b) * 6144 + 5120 + col); }
        for (int tok = t0; tok < t0 + TPW; ++tok) {
            f32x4 v[4];
#pragma unroll
            for (int j = 0; j < 4; ++j) {
                if (MODE == 0) v[j] = *(const f32x4*)(A.in[I_X] + (size_t)tok * D + 4 * (64 * j + F.lane));
                else { const u32x2 w = *(const u32x2*)((const bf16*)(F.ws + WS_X1) + (size_t)tok * D + 4 * (64 * j + F.lane)); v[j] = (f32x4){bflo(w.x), bfhi(w.x), bflo(w.y), bfhi(w.y)}; } }
            if (MODE != 0) {
                f32x4 a[4];
#pragma unroll
                for (int j = 0; j < 4; ++j) a[j] = (f32x4){0.f, 0.f, 0.f, 0.f};
#pragma unroll
                for (int k = 0; k < 4; ++k) { const unsigned ts = tokslot[tok * 4 + k]; const float gk = tokgate[tok * 4 + k] * (1.0f / Y8_SCALE);
                    const size_t row = (size_t)tab[ts >> 16] * 256 + (ts & 0xffffu); const unsigned char* yr = Y + row * D;
#pragma unroll
                    for (int j = 0; j < 4; ++j) { const int w = *(const int*)(yr + 4 * (64 * j + F.lane)); const f32x2 lo = __builtin_amdgcn_cvt_pk_f32_fp8(w, false), hi = __builtin_amdgcn_cvt_pk_f32_fp8(w, true);
                        a[j] += gk * (f32x4){lo.x, lo.y, hi.x, hi.y}; } }
#pragma unroll
                for (int j = 0; j < 4; ++j) { v[j] += g2[j] * a[j]; *(f32x4*)(F.out + (size_t)tok * D + 4 * (64 * j + F.lane)) = v[j]; }
            }
            if (MODE != 2) {
                float ss = 0.f;
#pragma unroll
                for (int j = 0; j < 4; ++j) ss += (v[j].x * v[j].x + v[j].y * v[j].y) + (v[j].z * v[j].z + v[j].w * v[j].w);
                const float rstd = 1.0f / sqrtf(wave_sum(ss) * (1.0f / D) + NORM_EPS);
#pragma unroll
                for (int j = 0; j < 4; ++j) { const f32x4 h = v[j] * rstd * g1[j] * sc[j] + sh[j]; u32x2 w; w.x = cvt_pk_bf16(h.x, h.y); w.y = cvt_pk_bf16(h.z, h.w);
                    *(u32x2*)(H + (size_t)tok * D + 4 * (64 * j + F.lane)) = w; }
            }
        }
    }
}

__device__ __forceinline__ NOPK u32x4 ldg16(const bf16* p) { return *(const u32x4*)p; }
__device__ __forceinline__ NOPK void unpack8(const u32x4 w, float (&f)[8]) { f[0] = bflo(w.x); f[1] = bfhi(w.x); f[2] = bflo(w.y); f[3] = bfhi(w.y); f[4] = bflo(w.z); f[5] = bfhi(w.z); f[6] = bflo(w.w); f[7] = bfhi(w.w); }
__device__ __forceinline__ NOPK void shifted8(const bf16* Z, size_t tokrow, bool has_prev, int col, const float* mu, float (&o)[8]) {
    float c[8], p[8]; unpack8(ldg16(Z + tokrow * C_IN + col), c);
    if (has_prev) unpack8(ldg16(Z + (tokrow - 1) * C_IN + col), p); else {
#pragma unroll
        for (int i = 0; i < 8; ++i) p[i] = 0.f; }
    const f32x4 m0 = *(const f32x4*)(mu + col), m1 = *(const f32x4*)(mu + col + 4);
#pragma unroll
    for (int i = 0; i < 8; ++i) o[i] = c[i] + (p[i] - c[i]) * (i < 4 ? m0[i] : m1[i - 4]);
}
__device__ __forceinline__ NOPK void ld8f(const float* p, float (&o)[8]) { const f32x4 a = *(const f32x4*)p, b = *(const f32x4*)(p + 4); o[0] = a.x; o[1] = a.y; o[2] = a.z; o[3] = a.w; o[4] = b.x; o[5] = b.y; o[6] = b.z; o[7] = b.w; }
__device__ __forceinline__ NOPK void lds8f(const LAS float* p, float (&o)[8]) { const f32x4 a = *(const LAS f32x4*)p, b = *(const LAS f32x4*)(p + 4); o[0] = a.x; o[1] = a.y; o[2] = a.z; o[3] = a.w; o[4] = b.x; o[5] = b.y; o[6] = b.z; o[7] = b.w; }
__device__ __forceinline__ NOPK bf16x8 pack8(const float (&f)[8]) { u32x4 w; w.x = cvt_pk_bf16(f[0], f[1]); w.y = cvt_pk_bf16(f[2], f[3]); w.z = cvt_pk_bf16(f[4], f[5]); w.w = cvt_pk_bf16(f[6], f[7]); return __builtin_bit_cast(bf16x8, w); }

__device__ __forceinline__ NOPK void n2r_phase(Frame& F, const Args& A, int l) {
    constexpr int XP = 1032, XBUF = 33 * 1024;
    LAS float* SS = (LAS float*)(F.lds + 2 * XBUF);
    LAS float* PL = SS + 128;
    LAS float* LG = PL + 8 * 512;
    LAS unsigned* ent = (LAS unsigned*)(LG + 512 + 128);
    LAS unsigned* lcnt = ent + 2048; LAS unsigned* lbase = lcnt + 32;
    LAS float* GG = (LAS float*)(lbase + 32); LAS float* SH = GG + 1024;
    static_assert(2 * XBUF + (128 + 4096 + 640) * 4 + 8192 + 256 + 8192 <= MISC_OFF, "n2r LDS map");
    if (F.tid < 32) lcnt[F.tid] = 0u;
    const float* mod = (const float*)(F.ws + WS_MOD);
    const bf16* X1 = (const bf16*)(F.ws + WS_X1);
    unsigned char* H8 = F.ws + WS_H;
    unsigned* gcnt = (unsigned*)(F.ws + WS_CTL) + CW_CNT + 64 * l;
    int* rowtok = (int*)(F.ws + WS_ROWTOK); unsigned* tokslot = (unsigned*)(F.ws + WS_TOKSLOT); float* tokgate = (float*)(F.ws + WS_TOKGATE);
    const int fr = F.lane & 15, kq = F.lane >> 4, w = F.wave;
    bf16x8 WB[4][2][2];
    { const bf16* src = (const bf16*)(F.ws + WS_LORA + (size_t)l * LORA_STRIDE + LO_RWS);
#pragma unroll
      for (int ks = 0; ks < 4; ++ks)
#pragma unroll
          for (int nb = 0; nb < 2; ++nb)
#pragma unroll
              for (int hl = 0; hl < 2; ++hl) WB[ks][nb][hl] = *(const bf16x8*)(src + (size_t)hl * NE * D + (size_t)(16 * nb + fr) * D + 128 * w + 32 * ks + 8 * kq); }
    const float rb = A.in[I_RB][l * NE + (F.lane & 31)];
#define N2_DMA(TILE, BUF) do { _Pragma("unroll") for (int k_ = 0; k_ < 5; ++k_) { const int i_ = w + 8 * k_; if (i_ < 33) { const int P_ = i_ * 64 + F.lane; int row_ = P_ / 129; const int pc_ = P_ - row_ * 129; \
            const bool ok_ = row_ < 16 && pc_ < 128; row_ = row_ < 16 ? row_ : 15; \
            __builtin_amdgcn_global_load_lds((const unsigned*)(X1 + (size_t)(blk * 256 + (TILE) * 16 + row_) * D + (ok_ ? pc_ * 8 : 0)), (LAS unsigned*)(F.lds + (BUF) * XBUF + i_ * 1024), 16, 0, 0); } } } while (0)
    for (int blk = F.bid; blk < M / 256; blk += F.G) {
        const int b = (blk * 256) / SEQ;
        const float* g2p = A.in[I_N2G] + (size_t)l * D; const float* shp = mod + ((size_t)l * 32 + b) * 6144 + 3072; const float* scp = shp + 1024;
        N2_DMA(0, 0);
        for (int i = F.tid; i < D; i += 512) { GG[i] = g2p[i] * (1.0f + scp[i]); SH[i] = shp[i]; }
#pragma unroll 1
        for (int tile = 0; tile < 16; ++tile) {
            if (tile + 1 < 16) { N2_DMA(tile + 1, (tile + 1) & 1); if (w == 0) asm volatile("s_waitcnt vmcnt(5)" ::: "memory"); else asm volatile("s_waitcnt vmcnt(4)" ::: "memory"); }
            else asm volatile("s_waitcnt vmcnt(0)" ::: "memory");
            LDS_BARRIER();
            const LAS bf16* xt = (const LAS bf16*)(F.lds + (tile & 1) * XBUF) + fr * XP + 128 * w + 8 * kq;
            float x[4][8]; float ss = 0.f;
#pragma unroll
            for (int ks = 0; ks < 4; ++ks) { unpack8(*(const LAS u32x4*)(xt + 32 * ks), x[ks]);
#pragma unroll
                for (int i = 0; i < 8; ++i) ss += x[ks][i] * x[ks][i]; }
            ss += __shfl_xor(ss, 16); ss += __shfl_xor(ss, 32);
            if (kq == 0) SS[w * 16 + fr] = ss;
            LDS_BARRIER();
            float tot = 0.f;
#pragma unroll
            for (int ww = 0; ww < 8; ++ww) tot += SS[ww * 16 + fr];
            const float rstd = 1.0f / sqrtf(tot * (1.0f / D) + NORM_EPS);
            const int tok = blk * 256 + tile * 16 + fr;
            f32x4 acc0 = (f32x4){0.f, 0.f, 0.f, 0.f}, acc1 = acc0;
#pragma unroll
            for (int ks = 0; ks < 4; ++ks) { const int col = 128 * w + 32 * ks + 8 * kq;
                float g[8], sh[8], lo[8]; lds8f(GG + col, g); lds8f(SH + col, sh);
#pragma unroll
                for (int i = 0; i < 8; ++i) x[ks][i] = x[ks][i] * rstd * g[i] + sh[i];
                const bf16x8 hi8 = pack8(x[ks]); const u32x4 hw = __builtin_bit_cast(u32x4, hi8);
                { u32x2 q8; q8.x = pk_fp8x4(__builtin_amdgcn_fmed3f(x[ks][0], -448.f, 448.f), __builtin_amdgcn_fmed3f(x[ks][1], -448.f, 448.f), __builtin_amdgcn_fmed3f(x[ks][2], -448.f, 448.f), __builtin_amdgcn_fmed3f(x[ks][3], -448.f, 448.f));
                  q8.y = pk_fp8x4(__builtin_amdgcn_fmed3f(x[ks][4], -448.f, 448.f), __builtin_amdgcn_fmed3f(x[ks][5], -448.f, 448.f), __builtin_amdgcn_fmed3f(x[ks][6], -448.f, 448.f), __builtin_amdgcn_fmed3f(x[ks][7], -448.f, 448.f));
                  *(u32x2*)(H8 + (size_t)tok * D + col) = q8; }
                lo[0] = x[ks][0] - bflo(hw.x); lo[1] = x[ks][1] - bfhi(hw.x); lo[2] = x[ks][2] - bflo(hw.y); lo[3] = x[ks][3] - bfhi(hw.y); lo[4] = x[ks][4] - bflo(hw.z); lo[5] = x[ks][5] - bfhi(hw.z); lo[6] = x[ks][6] - bflo(hw.w); lo[7] = x[ks][7] - bfhi(hw.w);
                const bf16x8 lo8 = pack8(lo);
                acc0 = __builtin_amdgcn_mfma_f32_16x16x32_bf16(hi8, WB[ks][0][0], acc0, 0, 0, 0); acc1 = __builtin_amdgcn_mfma_f32_16x16x32_bf16(hi8, WB[ks][1][0], acc1, 0, 0, 0);
                acc0 = __builtin_amdgcn_mfma_f32_16x16x32_bf16(lo8, WB[ks][0][0], acc0, 0, 0, 0); acc1 = __builtin_amdgcn_mfma_f32_16x16x32_bf16(lo8, WB[ks][1][0], acc1, 0, 0, 0);
                acc0 = __builtin_amdgcn_mfma_f32_16x16x32_bf16(hi8, WB[ks][0][1], acc0, 0, 0, 0); acc1 = __builtin_amdgcn_mfma_f32_16x16x32_bf16(hi8, WB[ks][1][1], acc1, 0, 0, 0); }
#pragma unroll
            for (int j = 0; j < 4; ++j) { PL[w * 512 + (4 * kq + j) * 32 + fr] = acc0[j]; PL[w * 512 + (4 * kq + j) * 32 + 16 + fr] = acc1[j]; }
            LDS_BARRIER();
            {
                const int tt = 2 * w + (F.lane >> 5), e = F.lane & 31;
                float logit = rb;
#pragma unroll
                for (int ww = 0; ww < 8; ++ww) logit += PL[ww * 512 + tt * 32 + e];
                LG[tt * 32 + e] = logit;
                LDS_WAIT(); asm volatile("" ::: "memory");
                int rank = 0;
#pragma unroll
                for (int q = 0; q < 8; ++q) { const f32x4 o = *(const LAS f32x4*)(LG + tt * 32 + 4 * q);
#pragma unroll
                    for (int j = 0; j < 4; ++j) { const int e2 = 4 * q + j; rank += (o[j] > logit || (o[j] == logit && e2 < e)) ? 1 : 0; } }
                if (rank < 4) { LG[512 + tt * 8 + rank] = __int_as_float(e); LG[512 + tt * 8 + 4 + rank] = logit; }
                LDS_WAIT(); asm volatile("" ::: "memory");
                if (e < 4) {
                    const f32x4 sv = *(const LAS f32x4*)(LG + 512 + tt * 8 + 4);
                    const float inv = 1.0f / (((1.0f + __expf(sv.y - sv.x)) + __expf(sv.z - sv.x)) + __expf(sv.w - sv.x));
                    const int ek = __float_as_int(LG[512 + tt * 8 + e]); const float gk = __expf(LG[512 + tt * 8 + 4 + e] - sv.x) * inv;
                    const unsigned rk = __hip_atomic_fetch_add(lcnt + ek, 1u, __ATOMIC_RELAXED, __HIP_MEMORY_SCOPE_WORKGROUP);
                    ent[((tile * 16 + tt) * 4 + e) * 2] = ((unsigned)ek << 16) | rk; ent[((tile * 16 + tt) * 4 + e) * 2 + 1] = __float_as_uint(gk); }
            }
        }
        __syncthreads();
        if (F.tid < 32) lbase[F.tid] = atomicAdd(gcnt + F.tid, lcnt[F.tid]);
        __syncthreads();
        for (int idx = F.tid; idx < 1024; idx += 512) { const unsigned wv = ent[idx * 2]; const int ek = wv >> 16; const unsigned slot = lbase[ek] + (wv & 0xffffu); const int tok = blk * 256 + (idx >> 2);
            rowtok[ek * ECAP + slot] = tok; tokslot[tok * 4 + (idx & 3)] = ((unsigned)ek << 16) | slot; tokgate[tok * 4 + (idx & 3)] = __uint_as_float(ent[idx * 2 + 1]); }
        __syncthreads();
        if (F.tid < 32) lcnt[F.tid] = 0u;
        __syncthreads();
    }
#undef N2_DMA
}

__device__ __forceinline__ NOPK void prep_phase(Frame& F, const Args& A, int l) {
    const bf16* Z = (const bf16*)(F.ws + WS_Z);
    const unsigned char* lo = F.ws + WS_LORA + (size_t)l * LORA_STRIDE;
    const bf16* dupT = (const bf16*)(lo + LO_DUP); const bf16* iupT = (const bf16*)(lo + LO_IUP); const bf16* gupT = (const bf16*)(lo + LO_GUP);
    const bf16* vrdT = (const bf16*)(lo + LO_VRD); const bf16* vruT = (const bf16*)(lo + LO_VRU);
    bf16* OPS = (bf16*)(F.ws + WS_OPS); bf16* QN = (bf16*)(F.ws + WS_QN); bf16* KN = (bf16*)(F.ws + WS_KN); bf16* VF = (bf16*)(F.ws + WS_VF); bf16* VFIRST = (bf16*)(F.ws + WS_VFIRST); float* BON = (float*)(F.ws + WS_BON);
    constexpr int ZROW = 1544, ZBUF = 53248, AFROW = 264, AF_OFF = 2 * ZBUF, SW_OFF = AF_OFF + 16 * AFROW * 2, MA_OFF = SW_OFF + 8 * 2048, PT_OFF = MA_OFF + 4096;
    constexpr int PT_MU = 0, PT_DW0 = 1792, PT_IA0 = 2304, PT_KK = 2816, PT_KA = 3328, PT_VRB = 3840, PT_QG = 4352, PT_KG = 4416, PT_RK = 4480, PT_N = 4992;
    static_assert(PT_OFF + PT_N * 4 <= MISC_OFF, "prep LDS map");
    LAS bf16* AF = (LAS bf16*)(F.lds + AF_OFF);
    LAS bf16* sW = (LAS bf16*)(F.lds + SW_OFF + F.wave * 2048);
    LAS float* PT = (LAS float*)(F.lds + PT_OFF);
    const int h = F.wave, lane0 = F.lane;
    for (int i = F.tid; i < PT_N; i += 512) {
        float v;
        if (i < PT_DW0) v = A.in[I_MU][(size_t)l * C_RWKV + i];
        else if (i < PT_IA0) v = A.in[I_DW0][l * DR + i - PT_DW0];
        else if (i < PT_KK) v = A.in[I_IA0][l * DR + i - PT_IA0];
        else if (i < PT_KA) v = A.in[I_KK][l * DR + i - PT_KK];
        else if (i < PT_VRB) v = A.in[I_KA][l * DR + i - PT_KA];
        else if (i < PT_QG) v = A.in[I_VRB][i - PT_VRB];
        else if (i < PT_KG) v = A.in[I_QG][l * HD + i - PT_QG];
        else if (i < PT_RK) v = A.in[I_KG][l * HD + i - PT_KG];
        else v = A.in[I_RK][l * DR + i - PT_RK];
        PT[i] = v;
    }
    { LAS float* m = (LAS float*)(F.lds + MA_OFF); m[F.tid] = 0.f; m[512 + F.tid] = 0.f; }
#define PREP_DMA(uu, buf) do { const int tk0_ = (uu) * 16; _Pragma("unroll") for (int k_ = 0; k_ < 7; ++k_) { const int i_ = F.wave + 8 * k_; if (i_ < 52) { int ln_ = lane; asm volatile("" : "+v"(ln_)); const int P_ = i_ * 64 + ln_; int row_ = P_ / 193; const int pc_ = P_ - row_ * 193; \
        const bool ok_ = row_ < 17; row_ = ok_ ? row_ : 16; const int spc_ = (ok_ && pc_ < 192) ? pc_ : 0; int tg_ = tk0_ - 1 + row_; tg_ = tg_ < 0 ? 0 : tg_; \
        __builtin_amdgcn_global_load_lds((const unsigned*)(Z + (size_t)tg_ * C_IN + spc_ * 8), (LAS unsigned*)(F.lds + (buf) * ZBUF + i_ * 1024), 16, 0, 0); } } } while (0)
#define PREP_LDR(uu) do { const size_t tk_ = (size_t)(uu) * 16 + tau; aq0 = ldg16(Z + tk_ * C_IN + 1792 + hc); aq1 = ldg16(Z + tk_ * C_IN + 1792 + hc + 32); ak0 = ldg16(Z + tk_ * C_IN + 2304 + hc); ak1 = ldg16(Z + tk_ * C_IN + 2304 + hc + 32); \
        av0 = ldg16(Z + tk_ * C_IN + 2816 + hc); av1 = ldg16(Z + tk_ * C_IN + 2816 + hc + 32); \
        const size_t tf_ = (size_t)(uu) * 16 + fr; lcC = ldg16(Z + tf_ * C_IN + 1536 + 32 * h + 8 * kq); lcP = ldg16(Z + (tf_ > 0 ? tf_ - 1 : 0) * C_IN + 1536 + 32 * h + 8 * kq); } while (0)
#define ZSH8(rr, hasp, col, OUT) do { float c_[8], p_[8], m_[8]; unpack8(*(const LAS u32x4*)(ZS + ((rr) + 1) * ZROW + (col)), c_); unpack8(*(const LAS u32x4*)(ZS + (rr) * ZROW + (col)), p_); lds8f(PT + PT_MU + (col), m_); \
            _Pragma("unroll") for (int i_ = 0; i_ < 8; ++i_) { const float pp_ = (hasp) ? p_[i_] : 0.f; OUT[i_] = c_[i_] + (pp_ - c_[i_]) * m_[i_]; } } while (0)
#define ZSH16(rr, hasp, col, OUT) do { ZSH8(rr, hasp, col, (*(float(*)[8])&OUT[0])); ZSH8(rr, hasp, (col) + 32, (*(float(*)[8])&OUT[8])); } while (0)
#define PREP_LDB(BF, WT, KD, NKS) do { int fo_ = (64 * h + fr) * (KD) + 8 * kq; asm volatile("" : "+v"(fo_));     \
        _Pragma("unroll") for (int nb_ = 0; nb_ < 4; ++nb_) _Pragma("unroll") for (int ks_ = 0; ks_ < (NKS); ++ks_) BF[nb_][ks_] = *(const bf16x8*)((WT) + fo_ + 16 * nb_ * (KD) + 32 * ks_); } while (0)
#define PREP_LORA(BF, ACOL, NKS) do { bf16x8 Af_[NKS]; _Pragma("unroll") for (int ks_ = 0; ks_ < (NKS); ++ks_) Af_[ks_] = *(const LAS bf16x8*)(AF + fr * AFROW + (ACOL) + 32 * ks_ + 8 * kq); \
        _Pragma("unroll") for (int nb_ = 0; nb_ < 4; ++nb_) { f32x4 acc_ = (f32x4){0.f, 0.f, 0.f, 0.f}; \
            _Pragma("unroll") for (int ks_ = 0; ks_ < (NKS); ++ks_) acc_ = __builtin_amdgcn_mfma_f32_16x16x32_bf16(Af_[ks_], BF[nb_][ks_], acc_, 0, 0, 0); \
            _Pragma("unroll") for (int j_ = 0; j_ < 4; ++j_) sW[(4 * kq + j_) * 64 + 16 * nb_ + fr] = (bf16)(cvt_pk_bf16(acc_[j_], 0.f) & 0xffffu); } \
        LDS_WAIT(); asm volatile("" ::: "memory"); } while (0)
#define SW16(OUT) do { unpack8(*(const LAS u32x4*)(sW + tau * 64 + 8 * q), (*(float(*)[8])&OUT[0])); unpack8(*(const LAS u32x4*)(sW + tau * 64 + 8 * q + 32), (*(float(*)[8])&OUT[8])); } while (0)
#define PT16(OFF, OUT) do { lds8f(PT + (OFF), (*(float(*)[8])&OUT[0])); lds8f(PT + (OFF) + 32, (*(float(*)[8])&OUT[8])); } while (0)
#define ST16(DST, V) do { *(u32x4*)(DST) = __builtin_bit_cast(u32x4, pack8(*(const float(*)[8])&V[0])); *(u32x4*)((DST) + 32) = __builtin_bit_cast(u32x4, pack8(*(const float(*)[8])&V[8])); } while (0)
#define ST16O(DST, V) do { *(u32x4*)(DST) = __builtin_bit_cast(u32x4, pack8(*(const float(*)[8])&V[0])); *(u32x4*)((DST) + 512) = __builtin_bit_cast(u32x4, pack8(*(const float(*)[8])&V[8])); } while (0)
    constexpr int NU = M / 16;
    u32x4 aq0, aq1, ak0, ak1, av0, av1, lcC, lcP;
    int u = F.bid, par = 0;
    if (u < NU) { const int lane = lane0, fr = lane & 15, kq = lane >> 4, tau = lane >> 2, q = lane & 3, hc = 64 * h + 8 * q; PREP_DMA(u, 0); PREP_LDR(u); }
    bool first = true;
    for (; u < NU; u += F.G, par ^= 1) {
        int lane = lane0; asm volatile("" : "+v"(lane));
        const int fr = lane & 15, kq = lane >> 4, tau = lane >> 2, q = lane & 3, hc = 64 * h + 8 * q;
        const int b = u >> 7, t0 = (u & 127) * 16, tok0 = u * 16, un = u + F.G;
        const size_t tok = (size_t)tok0 + tau; const int tpos = t0 + tau; const bool hp = tpos > 0;
        if (first) asm volatile("s_waitcnt vmcnt(0)" ::: "memory"); else asm volatile("s_waitcnt vmcnt(6)" ::: "memory");
        first = false;
        LDS_BARRIER();
        bf16x8 Bw[4][2], Ba[4][2], Bg[4][4], Bv[4][1];
        PREP_LDB(Bw, dupT, 64, 2);
        if (un < NU) PREP_DMA(un, par ^ 1);
        const LAS bf16* ZS = (const LAS bf16*)(F.lds + par * ZBUF);
        LAS float* MAc = (LAS float*)(F.lds + MA_OFF + par * 2048);
        { float x[16]; unpack8(aq0, *(float(*)[8])&x[0]); unpack8(aq1, *(float(*)[8])&x[8]);
          float s = 0.f;
#pragma unroll
          for (int i = 0; i < 16; ++i) s += x[i] * x[i];
          s = red4(s); const float r = 0.125f / sqrtf(s * (1.0f / 64.0f) + NORM_EPS);
          float gq[16]; PT16(PT_QG + 8 * q, gq);
#pragma unroll
          for (int i = 0; i < 16; ++i) x[i] = x[i] * r * gq[i];
          bf16* o = QN + (((size_t)b * NH + h) * SEQ + tpos) * 64 + 8 * q; ST16(o, x); }
        { float x[16]; unpack8(ak0, *(float(*)[8])&x[0]); unpack8(ak1, *(float(*)[8])&x[8]);
          float s = 0.f;
#pragma unroll
          for (int i = 0; i < 16; ++i) s += x[i] * x[i];
          s = red4(s); const float r = 1.0f / sqrtf(s * (1.0f / 64.0f) + NORM_EPS);
          float gk[16]; PT16(PT_KG + 8 * q, gk);
#pragma unroll
          for (int i = 0; i < 16; ++i) x[i] = x[i] * r * gk[i];
          bf16* o = KN + (((size_t)b * NH + h) * SEQ + tpos) * 64 + 8 * q; ST16(o, x); }
        { const unsigned vw[8] = {av0.x, av0.y, av0.z, av0.w, av1.x, av1.y, av1.z, av1.w};
          const int hh = (tau >> 2) & 1, jj = 4 * (tau >> 3) + (tau & 3);
          LAS bf16* sT = sW;
#pragma unroll
          for (int i = 0; i < 16; ++i) { const int d = 8 * q + (i & 7) + 32 * (i >> 3); sT[(hh * 64 + d) * 8 + jj] = (bf16)((i & 1) ? (vw[i >> 1] >> 16) : (vw[i >> 1] & 0xffffu)); }
          LDS_WAIT(); asm volatile("" ::: "memory");
          const u32x4 o0 = *(const LAS u32x4*)(sT + 8 * lane), o1 = *(const LAS u32x4*)(sT + 512 + 8 * lane);
          bf16* o = VF + ((((size_t)b * NH + h) * 128 + (tpos >> 4)) * 1024) + 8 * lane;
          *(u32x4*)o = o0; *(u32x4*)(o + 512) = o1;
          LDS_WAIT(); asm volatile("" ::: "memory"); }
        { float c_[8], p_[8], m_[8], x[8]; unpack8(lcC, c_); unpack8(lcP, p_); lds8f(PT + PT_MU + 1536 + 32 * h + 8 * kq, m_); const bool hpf = (t0 + fr) > 0;
#pragma unroll
          for (int i = 0; i < 8; ++i) { const float pp = hpf ? p_[i] : 0.f; x[i] = c_[i] + (pp - c_[i]) * m_[i]; x[i] = h < 2 ? ftanh(x[i]) : (h < 4 ? x[i] : fsigmoid(x[i])); }
          *(LAS u32x4*)(AF + fr * AFROW + 32 * h + 8 * kq) = __builtin_bit_cast(u32x4, pack8(x)); }
        if (l == 1) {
            f32x4 m0 = (f32x4){0.f, 0.f, 0.f, 0.f}, m1 = m0;
#pragma unroll
            for (int k2 = 0; k2 < 2; ++k2) { const int ks = 2 * h + k2; float x[8]; ZSH8(fr, (t0 + fr) > 0, 1024 + 32 * ks + 8 * kq, x); const bf16x8 a = pack8(x);
                m0 = __builtin_amdgcn_mfma_f32_16x16x32_bf16(a, *(const bf16x8*)(vrdT + (size_t)fr * DR + 32 * ks + 8 * kq), m0, 0, 0, 0);
                m1 = __builtin_amdgcn_mfma_f32_16x16x32_bf16(a, *(const bf16x8*)(vrdT + (size_t)(16 + fr) * DR + 32 * ks + 8 * kq), m1, 0, 0, 0); }
#pragma unroll
            for (int j = 0; j < 4; ++j) {
                LDS_IADD((LAS int*)MAc + (4 * kq + j) * 32 + fr, (int)__builtin_rintf(__builtin_amdgcn_fmed3f(m0[j], -8000.f, 8000.f) * 262144.f));
                LDS_IADD((LAS int*)MAc + (4 * kq + j) * 32 + 16 + fr, (int)__builtin_rintf(__builtin_amdgcn_fmed3f(m1[j], -8000.f, 8000.f) * 262144.f)); }
        }
        if (un < NU) PREP_LDR(un);
        PREP_LDB(Ba, iupT, 64, 2);
        LDS_BARRIER();
        u32x4 vf0, vf1;
        if (l == 1) { vf0 = ldg16(VFIRST + tok * DR + hc); vf1 = ldg16(VFIRST + tok * DR + hc + 32);
            if (F.wave == 0) { LAS f32x4* z = (LAS f32x4*)(F.lds + MA_OFF + (par ^ 1) * 2048); z[lane] = (f32x4){0.f, 0.f, 0.f, 0.f}; z[64 + lane] = (f32x4){0.f, 0.f, 0.f, 0.f}; } }
        bf16* op = OPS + ((((size_t)b * NH + h) * (SEQ / 16) + (tpos >> 4)) * 7) * 1024 + (tpos & 15) * 32 + 8 * q;
        float k16[16]; ZSH16(tau, hp, 512 + hc, k16);
        float kinv;
        { float kk16[16]; PT16(PT_KK + hc, kk16); float ssq = 0.f;
#pragma unroll
          for (int i = 0; i < 16; ++i) { const float t = k16[i] * kk16[i]; ssq += t * t; }
          ssq = red4(ssq); kinv = 1.0f / fmaxf(sqrtf(ssq), 1e-12f); }
        { PREP_LORA(Bw, 0, 2); float wl[16], p0[16]; SW16(wl); PT16(PT_DW0 + hc, p0);
#pragma unroll
          for (int i = 0; i < 16; ++i) wl[i] = -0.60653066f * fsigmoid(wl[i] + p0[i]);
          ST16O(op + 1 * 1024, wl); }
        u32x4 K4a, K4b, K5a, K5b, G6a, G6b;
        { PREP_LORA(Ba, 64, 2); PREP_LDB(Bg, gupT, 128, 4); float al[16], p1[16], p3[16], o[16]; SW16(al); PT16(PT_IA0 + hc, p1); PT16(PT_KA + hc, p3);
#pragma unroll
          for (int i = 0; i < 16; ++i) { al[i] = fsigmoid(al[i] + p1[i]); o[i] = k16[i] * (1.0f + (al[i] - 1.0f) * p3[i]); }
          ST16O(op + 2 * 1024, o);
          { float r16[16]; ZSH16(tau, hp, hc, r16); ST16O(op + 0 * 1024, r16); PT16(PT_RK + hc, p3);
            float bs = 0.f;
#pragma unroll
            for (int i = 0; i < 16; ++i) bs += r16[i] * o[i] * p3[i];
            bs = red4(bs); if (q == 0) BON[((size_t)b * NH + h) * SEQ + tpos] = bs; }
#pragma unroll
          PT16(PT_KK + hc, p1);
#pragma unroll
          for (int i = 0; i < 16; ++i) { o[i] = k16[i] * p1[i] * kinv; al[i] = o[i] * al[i]; }
          K4a = __builtin_bit_cast(u32x4, pack8(*(const float(*)[8])&o[0])); K4b = __builtin_bit_cast(u32x4, pack8(*(const float(*)[8])&o[8]));
          K5a = __builtin_bit_cast(u32x4, pack8(*(const float(*)[8])&al[0])); K5b = __builtin_bit_cast(u32x4, pack8(*(const float(*)[8])&al[8])); }
        { PREP_LORA(Bg, 128, 4); if (l == 1) PREP_LDB(Bv, vruT, 32, 1); G6a = *(const LAS u32x4*)(sW + tau * 64 + 8 * q); G6b = *(const LAS u32x4*)(sW + tau * 64 + 8 * q + 32); }
        { float v16[16]; ZSH16(tau, hp, 1024 + hc, v16);
          if (l == 1) {
              float am8[8]; { const i32x4 a0 = *(const LAS i32x4*)(MAc + fr * 32 + 8 * kq), a1 = *(const LAS i32x4*)(MAc + fr * 32 + 8 * kq + 4);
#pragma unroll
                  for (int i = 0; i < 4; ++i) { am8[i] = (float)a0[i] * (1.0f / 262144.f); am8[4 + i] = (float)a1[i] * (1.0f / 262144.f); } }
              const bf16x8 am = pack8(am8);
#pragma unroll
              for (int nb = 0; nb < 4; ++nb) {
                  const f32x4 avr = __builtin_amdgcn_mfma_f32_16x16x32_bf16(am, Bv[nb][0], (f32x4){0.f, 0.f, 0.f, 0.f}, 0, 0, 0);
#pragma unroll
                  for (int j = 0; j < 4; ++j) sW[(4 * kq + j) * 64 + 16 * nb + fr] = (bf16)(cvt_pk_bf16(avr[j], 0.f) & 0xffffu); }
              LDS_WAIT(); asm volatile("" ::: "memory");
              float vl[16], vb[16], vf[16]; SW16(vl); PT16(PT_VRB + hc, vb); unpack8(vf0, *(float(*)[8])&vf[0]); unpack8(vf1, *(float(*)[8])&vf[8]);
#pragma unroll
              for (int i = 0; i < 16; ++i) v16[i] = v16[i] + (vf[i] - v16[i]) * fsigmoid(vb[i] + vl[i]);
          } else { ST16(VFIRST + tok * DR + hc, v16); }
          ST16O(op + 3 * 1024, v16); }
        asm volatile("" ::: "memory");
        *(u32x4*)(op + 4 * 1024) = K4a; *(u32x4*)(op + 4 * 1024 + 512) = K4b; *(u32x4*)(op + 5 * 1024) = K5a; *(u32x4*)(op + 5 * 1024 + 512) = K5b; *(u32x4*)(op + 6 * 1024) = G6a; *(u32x4*)(op + 6 * 1024 + 512) = G6b;
        asm volatile("" ::: "memory");
    }
#undef PREP_DMA
#undef PREP_LDR
#undef ZSH8
#undef ZSH16
#undef PREP_LORA
#undef PREP_LDB
#undef SW16
#undef PT16
#undef ST16
#undef ST16O
}

__device__ __forceinline__ NOPK void rec_phase(Frame& F, const Args& A, int l) {
    const bf16* OPS = (const bf16*)(F.ws + WS_OPS); bf16* YC = (bf16*)(F.ws + WS_YCAT);
    constexpr int TCH = 32, BUF_F = 7 * TCH * 64;
    LAS float* buf = (LAS float*)F.lds; LAS float* ybuf = (LAS float*)(F.lds + 2 * BUF_F * 4);
    const int v0 = 8 * F.wave + 2 * (F.lane >> 4), seg = F.lane & 15;
    for (int bh = F.bid; bh < BATCH * NH; bh += F.G) {
        const int b = bh >> 3, h = bh & 7;
        const bf16* src = OPS + (size_t)bh * SEQ * 448;
        f32x4 S0 = (f32x4){0.f, 0.f, 0.f, 0.f}, S1 = S0;
        u32x4 pre[4];
#define REC_ISSUE(c_) do { _Pragma("unroll") for (int i_ = 0; i_ < 4; ++i_) { const int p_ = F.tid + 512 * i_; if (p_ < 1792) pre[i_] = *(const u32x4*)(src + (size_t)(c_) * TCH * 448 + 8 * p_); } } while (0)
#define REC_LAND(c_) do { LAS float* d_ = buf + ((c_) & 1) * BUF_F; _Pragma("unroll") for (int i_ = 0; i_ < 4; ++i_) { const int p_ = F.tid + 512 * i_; if (p_ < 1792) { const int e0_ = 8 * p_, st_ = e0_ / 448, rem_ = e0_ % 448, arr_ = rem_ >> 6, col_ = rem_ & 63; \
            float f_[8]; unpack8(pre[i_], f_); LAS float* o_ = d_ + (arr_ * TCH + st_) * 64 + col_; *(LAS f32x4*)o_ = (f32x4){f_[0], f_[1], f_[2], f_[3]}; *(LAS f32x4*)(o_ + 4) = (f32x4){f_[4], f_[5], f_[6], f_[7]}; } } } while (0)
#define REC_LD(s_, KK, W, BB, KQ, RQ, VV) do { const LAS float* q_ = B + (s_) * 64 + 4 * seg; RQ = *(const LAS f32x4*)(q_); W = *(const LAS f32x4*)(q_ + 1 * TCH * 64); KQ = *(const LAS f32x4*)(q_ + 2 * TCH * 64); \
            KK = *(const LAS f32x4*)(q_ + 4 * TCH * 64); BB = *(const LAS f32x4*)(q_ + 5 * TCH * 64); VV = *(const LAS f32x2*)(B + (3 * TCH + (s_)) * 64 + v0); } while (0)
        const f32x4 rk = *(const f32x4*)(A.in[I_RK] + (size_t)l * DR + 64 * h + 4 * (F.tid & 15)), lw = *(const f32x4*)(A.in[I_LNW] + (size_t)l * DR + 64 * h + 4 * (F.tid & 15)), lb = *(const f32x4*)(A.in[I_LNB] + (size_t)l * DR + 64 * h + 4 * (F.tid & 15));
        REC_ISSUE(0); REC_LAND(0); LDS_BARRIER();
        for (int c = 0; c < SEQ / TCH; ++c) {
            if (c + 1 < SEQ / TCH) REC_ISSUE(c + 1);
            const LAS float* B = buf + (c & 1) * BUF_F;
            f32x4 kk, w, bb, kq, rq; f32x2 vv;
            REC_LD(0, kk, w, bb, kq, rq, vv);
#pragma unroll 4
            for (int s = 0; s < TCH; ++s) {
                f32x4 nkk, nw, nbb, nkq, nrq; f32x2 nvv;
                { const int sn = (s + 1 < TCH) ? s + 1 : s; REC_LD(sn, nkk, nw, nbb, nkq, nrq, nvv); }
                float p0 = (S0.x * kk.x + S0.y * kk.y) + (S0.z * kk.z + S0.w * kk.w);
                float p1 = (S1.x * kk.x + S1.y * kk.y) + (S1.z * kk.z + S1.w * kk.w);
                const f32x4 u0 = S0 * w + vv.x * kq, u1 = S1 * w + vv.y * kq;
                float U0 = (u0.x * rq.x + u0.y * rq.y) + (u0.z * rq.z + u0.w * rq.w);
                float U1 = (u1.x * rq.x + u1.y * rq.y) + (u1.z * rq.z + u1.w * rq.w);
                float Br = (bb.x * rq.x + bb.y * rq.y) + (bb.z * rq.z + bb.w * rq.w);
                p0 = red16(p0); p1 = red16(p1); U0 = red16(U0); U1 = red16(U1); Br = red16(Br);
                S0 = u0 - p0 * bb; S1 = u1 - p1 * bb;
                if (seg == 0) *(LAS f32x2*)(ybuf + s * 64 + v0) = (f32x2){U0 - p0 * Br, U1 - p1 * Br};
                kk = nkk; w = nw; bb = nbb; kq = nkq; rq = nrq; vv = nvv;
            }
            LDS_BARRIER();
            {
                const int st = F.tid >> 4, part = F.tid & 15, c4 = 4 * part;
                const f32x4 y4 = *(const LAS f32x4*)(ybuf + st * 64 + c4);
                const float mean = red16((y4.x + y4.y) + (y4.z + y4.w)) * (1.0f / 64.0f);
                const f32x4 dv = y4 - mean;
                const float var = red16((dv.x * dv.x + dv.y * dv.y) + (dv.z * dv.z + dv.w * dv.w)) * (1.0f / 64.0f);
                const float rstd = 1.0f / sqrtf(var + GN_EPS);
                const f32x4 r4 = *(const LAS f32x4*)(B + (0 * TCH + st) * 64 + c4), k4 = *(const LAS f32x4*)(B + (2 * TCH + st) * 64 + c4), v4 = *(const LAS f32x4*)(B + (3 * TCH + st) * 64 + c4), g4 = *(const LAS f32x4*)(B + (6 * TCH + st) * 64 + c4);
                const float bon = red16((r4.x * k4.x * rk.x + r4.y * k4.y * rk.y) + (r4.z * k4.z * rk.z + r4.w * k4.w * rk.w));
                const f32x4 o = (dv * rstd * lw + lb + bon * v4) * g4;
                u32x2 w; w.x = cvt_pk_bf16(o.x, o.y); w.y = cvt_pk_bf16(o.z, o.w);
                *(u32x2*)(YC + ((size_t)b * SEQ + c * TCH + st) * D + 64 * h + c4) = w;
            }
            if (c + 1 < SEQ / TCH) REC_LAND(c + 1);
            LDS_BARRIER();
        }
    }
}

__device__ __forceinline__ NOPK void attn_waves(Frame& F, const Args& A, int l, int wu0, int wustride) {
    const bf16* QN = (const bf16*)(F.ws + WS_QN); const bf16* KN = (const bf16*)(F.ws + WS_KN); const bf16* VF = (const bf16*)(F.ws + WS_VF); bf16* YC = (bf16*)(F.ws + WS_YCAT);
    const int qi = F.lane & 31, hh = F.lane >> 5;
    LAS unsigned char* stg = F.lds + 4 * 33536 + (F.wave - 4) * 4352;
    for (int wu = wu0; wu < BATCH * NH * 64; wu += wustride) {
        const int bh = wu >> 6, b = bh >> 3, h = bh & 7;
        const int Q0 = 32 * (wu & 63);
        bf16x8 qf[4];
#pragma unroll
        for (int ks = 0; ks < 4; ++ks) qf[ks] = *(const bf16x8*)(QN + ((size_t)bh * SEQ + Q0 + qi) * 64 + 16 * ks + 8 * hh);
        f32x16 O0, O1;
#pragma unroll
        for (int i = 0; i < 16; ++i) { O0[i] = 0.f; O1[i] = 0.f; }
        float R = 1.f;
        const int kbd = Q0 >> 5;
        for (int kb = kbd; kb >= 0; --kb) {
            bf16x8 kf[4], vf[2][2];
#pragma unroll
            for (int ks = 0; ks < 4; ++ks) kf[ks] = *(const bf16x8*)(KN + ((size_t)bh * SEQ + 32 * kb + qi) * 64 + 16 * ks + 8 * hh);
#pragma unroll
            for (int s = 0; s < 2; ++s)
#pragma unroll
                for (int db = 0; db < 2; ++db) vf[s][db] = *(const bf16x8*)(VF + ((((size_t)bh * 128 + 2 * kb + s) * 2 + hh) * 64 + qi + 32 * db) * 8);
            f32x16 Sx;
#pragma unroll
            for (int i = 0; i < 16; ++i) Sx[i] = 0.f;
#pragma unroll
            for (int ks = 0; ks < 4; ++ks) Sx = __builtin_amdgcn_mfma_f32_32x32x16_bf16(kf[ks], qf[ks], Sx, 0, 0, 0);
            const bool diag = (kb == kbd);
            float kp[16], sg[16];
#pragma unroll
            for (int i = 0; i < 16; ++i) { const int rho = (i & 3) + 8 * (i >> 2) + 4 * hh; const bool valid = !diag || rho < qi; const float L = Sx[i];
                const float e = __builtin_amdgcn_exp2f(-1.44269504f * fabsf(L)), r = __builtin_amdgcn_rcpf(1.0f + e), er = e * r; const bool pos = L >= 0.f;
                kp[i] = valid ? (pos ? er : r) : 1.f; sg[i] = valid ? (pos ? r : er) : 0.f; }
            float Cx[16], G[4], Pg[4];
#pragma unroll
            for (int gi = 0; gi < 4; ++gi) { const float x2 = kp[4 * gi + 3], x1 = x2 * kp[4 * gi + 2], x0 = x1 * kp[4 * gi + 1]; Cx[4 * gi + 3] = 1.f; Cx[4 * gi + 2] = x2; Cx[4 * gi + 1] = x1; Cx[4 * gi] = x0; G[gi] = x0 * kp[4 * gi]; }
#pragma unroll
            for (int gi = 0; gi < 4; ++gi) Pg[gi] = __shfl_xor(G[gi], 32);
            float T[4]; { const float sa2 = G[3], sa1 = sa2 * G[2], sa0 = sa1 * G[1], sb2 = Pg[3], sb1 = sb2 * Pg[2], sb0 = sb1 * Pg[1];
                T[3] = 1.f; T[2] = sa2 * sb2; T[1] = sa1 * sb1; T[0] = sa0 * sb0;
                if (hh == 0) { T[3] *= Pg[3]; T[2] *= Pg[2]; T[1] *= Pg[1]; T[0] *= Pg[0]; } }
            const float tot = ((G[0] * G[1]) * (G[2] * G[3])) * ((Pg[0] * Pg[1]) * (Pg[2] * Pg[3]));
            float wg[16];
#pragma unroll
            for (int i = 0; i < 16; ++i) wg[i] = sg[i] * Cx[i] * (T[i >> 2] * R);
            R *= tot;
            const bf16x8 p0 = pack8(*(float(*)[8])&wg[0]), p1 = pack8(*(float(*)[8])&wg[8]);
            O0 = __builtin_amdgcn_mfma_f32_32x32x16_bf16(vf[0][0], p0, O0, 0, 0, 0); O1 = __builtin_amdgcn_mfma_f32_32x32x16_bf16(vf[0][1], p0, O1, 0, 0, 0);
            O0 = __builtin_amdgcn_mfma_f32_32x32x16_bf16(vf[1][0], p1, O0, 0, 0, 0); O1 = __builtin_amdgcn_mfma_f32_32x32x16_bf16(vf[1][1], p1, O1, 0, 0, 0);
            if (__all(R < 9.3576e-14f)) break;
        }
        float ss = 0.f;
#pragma unroll
        for (int i = 0; i < 16; ++i) ss += O0[i] * O0[i] + O1[i] * O1[i];
        ss += __shfl_xor(ss, 32);
        const float rstd = 1.0f / sqrtf(ss * (1.0f / 64.0f) + NORM_EPS);
        const float* og = A.in[I_SBG] + (size_t)l * DR + 64 * h;
#pragma unroll
        for (int db = 0; db < 2; ++db)
#pragma unroll
            for (int gi = 0; gi < 4; ++gi) { const int d = 32 * db + 8 * gi + 4 * hh; const f32x4 gq = *(const f32x4*)(og + d);
                const float o0 = (db ? O1[4 * gi] : O0[4 * gi]) * rstd * gq.x, o1 = (db ? O1[4 * gi + 1] : O0[4 * gi + 1]) * rstd * gq.y, o2 = (db ? O1[4 * gi + 2] : O0[4 * gi + 2]) * rstd * gq.z, o3 = (db ? O1[4 * gi + 3] : O0[4 * gi + 3]) * rstd * gq.w;
                u32x2 w; w.x = cvt_pk_bf16(o0, o1); w.y = cvt_pk_bf16(o2, o3); *(LAS u32x2*)(stg + qi * 136 + d * 2) = w; }
        LDS_WAIT(); asm volatile("" ::: "memory");
#pragma unroll
        for (int k = 0; k < 4; ++k) { const int row = 8 * k + (F.lane >> 3), un8 = F.lane & 7;
            const u32x2 lo_ = *(const LAS u32x2*)(stg + row * 136 + un8 * 16), hi_ = *(const LAS u32x2*)(stg + row * 136 + un8 * 16 + 8);
            *(u32x4*)(YC + ((size_t)b * SEQ + Q0 + row) * D + 512 + 64 * h + un8 * 8) = (u32x4){lo_.x, lo_.y, hi_.x, hi_.y}; }
        LDS_WAIT(); asm volatile("" ::: "memory");
    }
}

constexpr int CL = 32, NCH = SEQ / CL, CH_ELEMS = 12288;
constexpr size_t WS_CH = WS_Z;
#define CH_SWZ(row, col) (((((col) >> 3) ^ ((row) & 7)) << 3) | ((col) & 7))
constexpr int C1_LDS = 33536; static_assert(4 * C1_LDS + 4 * 4352 <= MISC_OFF, "c1 + attention staging LDS");
__device__ __forceinline__ NOPK bf16x8 acc_frag(const f32x16& a, int s) {
    float f[8];
#pragma unroll
    for (int i = 0; i < 8; ++i) f[i] = a[8 * s + i];
    return pack8(f);
}
__device__ __forceinline__ NOPK void c1_unit(Frame& F, int l, int bh, int c, LAS unsigned char* wl) {
    const bf16* OPS = (const bf16*)(F.ws + WS_OPS) + ((size_t)bh * SEQ + (size_t)c * CL) * 448;
    bf16* CH = (bf16*)(F.ws + WS_CH) + ((size_t)bh * NCH + c) * CH_ELEMS;
    constexpr int IP = 40, RP = 72, TP = 72;
    LAS bf16* KT = (LAS bf16*)wl; LAS bf16* VT = KT + 64 * IP; LAS bf16* KbT = VT + 64 * IP; LAS bf16* BbT = KbT + 64 * IP;
    LAS bf16* RtI = BbT + 64 * IP; LAS bf16* WvI = RtI + 32 * RP; LAS bf16* XI = WvI + 64 * IP; LAS float* cLs = (LAS float*)(WvI + 4096);
    LAS float* TB = (LAS float*)WvI;
    const int lane = F.lane, t = lane & 31, h = lane >> 5;
    const int trq = (lane & 15) >> 2, trp = lane & 3, trb = (lane >> 4) & 1;
#pragma unroll
    for (int n = 0; n < 4; ++n) { float w8[8]; unpack8(*(const u32x4*)(OPS + (t >> 4) * 7168 + 1 * 1024 + (n >> 1) * 512 + (t & 15) * 32 + 8 * (h + 2 * (n & 1))), w8);
        *(LAS f32x4*)(TB + t * 64 + 8 * (h + 2 * n)) = (f32x4){w8[0], w8[1], w8[2], w8[3]}; *(LAS f32x4*)(TB + t * 64 + 8 * (h + 2 * n) + 4) = (f32x4){w8[4], w8[5], w8[6], w8[7]}; }
    u32x4 rw[5][4];
#pragma unroll
    for (int a = 0; a < 5; ++a)
#pragma unroll
        for (int n = 0; n < 4; ++n) rw[a][n] = *(const u32x4*)(OPS + (t >> 4) * 7168 + (a == 0 ? 0 : a + 1) * 1024 + (n >> 1) * 512 + (t & 15) * 32 + 8 * (h + 2 * (n & 1)));
    LDS_WAIT(); asm volatile("" ::: "memory");
    float cLl;
    { float cs = 0.f;
#pragma unroll 8
      for (int s = 0; s < CL; ++s) { cs += TB[s * 64 + lane]; TB[s * 64 + lane] = cs; }
      cLl = cs; }
    LDS_WAIT(); asm volatile("" ::: "memory");
    bf16x8 fKap[4], fBt[4], fKt[4], fRt[4];
#pragma unroll
    for (int n = 0; n < 4; ++n) { const int j0 = 8 * (h + 2 * n);
        float ct[8], cl[8]; lds8f(TB + t * 64 + j0, ct); lds8f(TB + 31 * 64 + j0, cl);
        float r8[8], k8[8], ka8[8], be8[8], x[8];
        unpack8(rw[0][n], r8); unpack8(rw[1][n], k8); unpack8(rw[3][n], ka8); unpack8(rw[4][n], be8);
        float ep[8], en[8], ed[8], eq[8];
#pragma unroll
        for (int i = 0; i < 8; ++i) { ep[i] = __expf(ct[i]); en[i] = __expf(-ct[i]); ed[i] = __expf(cl[i] - ct[i]);
            const float sh_ = __int_as_float(__builtin_amdgcn_update_dpp(0, __float_as_int(ep[i]), 0x138, 0xf, 0xf, false));
            eq[i] = t > 0 ? sh_ : 1.0f; }
#pragma unroll
        for (int i = 0; i < 8; ++i) x[i] = ka8[i] * eq[i];
        fKap[n] = pack8(x); *(LAS u32x4*)(KT + t * TP + j0) = __builtin_bit_cast(u32x4, fKap[n]);
#pragma unroll
        for (int i = 0; i < 8; ++i) x[i] = be8[i] * en[i];
        fBt[n] = pack8(x);
#pragma unroll
        for (int i = 0; i < 8; ++i) x[i] = k8[i] * en[i];
        fKt[n] = pack8(x);
#pragma unroll
        for (int i = 0; i < 8; ++i) x[i] = r8[i] * ep[i];
        fRt[n] = pack8(x); *(LAS u32x4*)(RtI + t * RP + j0) = __builtin_bit_cast(u32x4, fRt[n]);
        *(LAS u32x4*)(VT + t * TP + j0) = rw[2][n];
#pragma unroll
        for (int i = 0; i < 8; ++i) x[i] = k8[i] * ed[i];
        *(LAS u32x4*)(KbT + t * TP + j0) = __builtin_bit_cast(u32x4, pack8(x));
#pragma unroll
        for (int i = 0; i < 8; ++i) x[i] = be8[i] * ed[i];
        *(LAS u32x4*)(BbT + t * TP + j0) = __builtin_bit_cast(u32x4, pack8(x));
        asm volatile("" ::: "memory"); }
    LDS_WAIT(); asm volatile("" ::: "memory");
    cLs[lane] = cLl;
    LDS_WAIT(); asm volatile("" ::: "memory");
    const f32x16 Z16 = {0.f, 0.f, 0.f, 0.f, 0.f, 0.f, 0.f, 0.f, 0.f, 0.f, 0.f, 0.f, 0.f, 0.f, 0.f, 0.f};
#define C1_ROW(i) (((i) & 3) + 8 * ((i) >> 2) + 4 * h)
#define C1_PUT(IMG, PITCH, ROW0, ACC) do { _Pragma("unroll") for (int g_ = 0; g_ < 4; ++g_) { u32x2 w_; w_.x = cvt_pk_bf16(ACC[4 * g_], ACC[4 * g_ + 1]); w_.y = cvt_pk_bf16(ACC[4 * g_ + 2], ACC[4 * g_ + 3]); \
        *(LAS u32x2*)(IMG + t * (PITCH) + (ROW0) + 8 * g_ + 4 * h) = w_; } LDS_WAIT(); asm volatile("" ::: "memory"); } while (0)
#define C1_TR(P_) __builtin_amdgcn_ds_read_tr16_b64_v4i16((LAS s16x4*)(P_))
#define C1_GETA(IMG, PITCH, ROW0, ks) ({ LAS bf16* b_ = (LAS bf16*)(IMG) + (16 * (ks) + 4 * h + trq) * (PITCH) + (ROW0) + 16 * trb + 4 * trp; const s16x4 lo_ = C1_TR(b_), hi_ = C1_TR(b_ + 8 * (PITCH)); \
        (bf16x8){lo_.x, lo_.y, lo_.z, lo_.w, hi_.x, hi_.y, hi_.z, hi_.w}; })
    f32x16 P = Z16;
#pragma unroll
    for (int ks = 0; ks < 4; ++ks) P = __builtin_amdgcn_mfma_f32_32x32x16_bf16(fBt[ks], fKap[ks], P, 0, 0, 0);
    f32x16 T;
#pragma unroll
    for (int i = 0; i < 16; ++i) { const int row = C1_ROW(i); P[i] = row < t ? -P[i] : 0.f; T[i] = P[i] + (row == t ? 1.f : 0.f); }
    C1_PUT(XI, IP, 0, P);
    bf16x8 aP0 = C1_GETA(XI, IP, 0, 0), aP1 = C1_GETA(XI, IP, 0, 1);
    LDS_WAIT(); asm volatile("" ::: "memory");
#pragma unroll 1
    for (int it = 0; it < 4; ++it) {
        const bf16x8 bP0 = acc_frag(P, 0), bP1 = acc_frag(P, 1);
        P = __builtin_amdgcn_mfma_f32_32x32x16_bf16(aP0, bP0, Z16, 0, 0, 0); P = __builtin_amdgcn_mfma_f32_32x32x16_bf16(aP1, bP1, P, 0, 0, 0);
        C1_PUT(XI, IP, 0, P);
        aP0 = C1_GETA(XI, IP, 0, 0); aP1 = C1_GETA(XI, IP, 0, 1);
        LDS_WAIT(); asm volatile("" ::: "memory");
        const bf16x8 bT0 = acc_frag(T, 0), bT1 = acc_frag(T, 1);
        T = __builtin_amdgcn_mfma_f32_32x32x16_bf16(aP0, bT0, T, 0, 0, 0); T = __builtin_amdgcn_mfma_f32_32x32x16_bf16(aP1, bT1, T, 0, 0, 0);
    }
    const bf16x8 bT0 = acc_frag(T, 0), bT1 = acc_frag(T, 1);
    f32x16 Akk = Z16, Qkr = Z16, Qbr = Z16;
#pragma unroll
    for (int ks = 0; ks < 4; ++ks) { Akk = __builtin_amdgcn_mfma_f32_32x32x16_bf16(fKt[ks], fKap[ks], Akk, 0, 0, 0); Qkr = __builtin_amdgcn_mfma_f32_32x32x16_bf16(fKt[ks], fRt[ks], Qkr, 0, 0, 0);
                                    Qbr = __builtin_amdgcn_mfma_f32_32x32x16_bf16(fBt[ks], fRt[ks], Qbr, 0, 0, 0); }
#pragma unroll
    for (int i = 0; i < 16; ++i) { const int row = C1_ROW(i); Akk[i] = row < t ? Akk[i] : 0.f; Qkr[i] = row <= t ? Qkr[i] : 0.f; Qbr[i] = row <= t ? Qbr[i] : 0.f; }
    const bf16x8 bQkr0 = acc_frag(Qkr, 0), bQkr1 = acc_frag(Qkr, 1), bQbr0 = acc_frag(Qbr, 0), bQbr1 = acc_frag(Qbr, 1);
    C1_PUT(XI, IP, 0, Akk);
    bf16x8 bM0, bM1;
    { const bf16x8 a0 = C1_GETA(XI, IP, 0, 0), a1 = C1_GETA(XI, IP, 0, 1);
      f32x16 M1 = __builtin_amdgcn_mfma_f32_32x32x16_bf16(a0, bT0, Z16, 0, 0, 0); M1 = __builtin_amdgcn_mfma_f32_32x32x16_bf16(a1, bT1, M1, 0, 0, 0);
      bM0 = acc_frag(M1, 0); bM1 = acc_frag(M1, 1); }
    bf16x8 aKh[2][2];
    { const bf16x8 a00 = C1_GETA(KT, TP, 0, 0), a01 = C1_GETA(KT, TP, 0, 1), a10 = C1_GETA(KT, TP, 32, 0), a11 = C1_GETA(KT, TP, 32, 1);
      LDS_WAIT(); asm volatile("" ::: "memory");
      f32x16 k0 = __builtin_amdgcn_mfma_f32_32x32x16_bf16(a00, bT0, Z16, 0, 0, 0); k0 = __builtin_amdgcn_mfma_f32_32x32x16_bf16(a01, bT1, k0, 0, 0, 0);
      f32x16 k1 = __builtin_amdgcn_mfma_f32_32x32x16_bf16(a10, bT0, Z16, 0, 0, 0); k1 = __builtin_amdgcn_mfma_f32_32x32x16_bf16(a11, bT1, k1, 0, 0, 0);
      C1_PUT(KT, TP, 0, k0); C1_PUT(KT, TP, 32, k1);
#pragma unroll
      for (int jb = 0; jb < 2; ++jb)
#pragma unroll
          for (int ks = 0; ks < 2; ++ks) aKh[jb][ks] = C1_GETA(KT, TP, 32 * jb, ks); }
    bf16x8 aVT[2][2], aWv[2][2];
#pragma unroll
    for (int vb = 0; vb < 2; ++vb)
#pragma unroll
        for (int ks = 0; ks < 2; ++ks) aVT[vb][ks] = C1_GETA(VT, TP, 32 * vb, ks);
    { f32x16 w0 = __builtin_amdgcn_mfma_f32_32x32x16_bf16(aVT[0][0], bM0, Z16, 0, 0, 0); w0 = __builtin_amdgcn_mfma_f32_32x32x16_bf16(aVT[0][1], bM1, w0, 0, 0, 0);
      f32x16 w1 = __builtin_amdgcn_mfma_f32_32x32x16_bf16(aVT[1][0], bM0, Z16, 0, 0, 0); w1 = __builtin_amdgcn_mfma_f32_32x32x16_bf16(aVT[1][1], bM1, w1, 0, 0, 0);
      C1_PUT(WvI, TP, 0, w0); C1_PUT(WvI, TP, 32, w1);
#pragma unroll
      for (int vb = 0; vb < 2; ++vb)
#pragma unroll
          for (int ks = 0; ks < 2; ++ks) aWv[vb][ks] = C1_GETA(WvI, TP, 32 * vb, ks); }
    LDS_WAIT(); asm volatile("" ::: "memory");
    LAS bf16* STG = (LAS bf16*)wl;
#define C1_ST4(BLK, ROWL, COL, a0_, a1_, a2_, a3_) do { u32x2 w_; w_.x = cvt_pk_bf16(a0_, a1_); w_.y = cvt_pk_bf16(a2_, a3_); *(LAS u32x2*)(STG + ((BLK) & 1) * 2048 + (ROWL) * 64 + CH_SWZ(ROWL, COL)) = w_; } while (0)
#define C1_FLUSH(BLK, GOFF) do { LDS_WAIT(); asm volatile("" ::: "memory"); _Pragma("unroll") for (int k_ = 0; k_ < 4; ++k_) { const u32x4 w_ = *(const LAS u32x4*)(STG + ((BLK) & 1) * 2048 + (k_ * 64 + lane) * 8); \
        *(u32x4*)(CH + (GOFF) + (k_ * 64 + lane) * 8) = w_; } } while (0)
#pragma unroll
    for (int jb = 0; jb < 2; ++jb) { f32x16 a = __builtin_amdgcn_mfma_f32_32x32x16_bf16(aKh[jb][0], bQbr0, Z16, 0, 0, 0); a = __builtin_amdgcn_mfma_f32_32x32x16_bf16(aKh[jb][1], bQbr1, a, 0, 0, 0);
#pragma unroll
        for (int g = 0; g < 4; ++g) { const int j0 = 32 * jb + 8 * g + 4 * h; const u32x2 rv = *(const LAS u32x2*)(RtI + t * RP + j0);
            C1_ST4(0, t, j0, bflo(rv.x) - a[4 * g], bfhi(rv.x) - a[4 * g + 1], bflo(rv.y) - a[4 * g + 2], bfhi(rv.y) - a[4 * g + 3]); } }
    C1_FLUSH(0, 8192);
#pragma unroll
    for (int vb = 0; vb < 2; ++vb) { f32x16 a = __builtin_amdgcn_mfma_f32_32x32x16_bf16(aVT[vb][0], bQkr0, Z16, 0, 0, 0); a = __builtin_amdgcn_mfma_f32_32x32x16_bf16(aVT[vb][1], bQkr1, a, 0, 0, 0);
        f32x16 s = __builtin_amdgcn_mfma_f32_32x32x16_bf16(aWv[vb][0], bQbr0, Z16, 0, 0, 0); s = __builtin_amdgcn_mfma_f32_32x32x16_bf16(aWv[vb][1], bQbr1, s, 0, 0, 0);
#pragma unroll
        for (int g = 0; g < 4; ++g) { const int v0 = 32 * vb + 8 * g + 4 * h; C1_ST4(1, t, v0, a[4 * g] - s[4 * g], a[4 * g + 1] - s[4 * g + 1], a[4 * g + 2] - s[4 * g + 2], a[4 * g + 3] - s[4 * g + 3]); } }
    C1_FLUSH(1, 10240);
#pragma unroll
    for (int jc = 0; jc < 2; ++jc) { const bf16x8 bB0 = C1_GETA(BbT, TP, 32 * jc, 0), bB1 = C1_GETA(BbT, TP, 32 * jc, 1), bK0 = C1_GETA(KbT, TP, 32 * jc, 0), bK1 = C1_GETA(KbT, TP, 32 * jc, 1);
        const int jp = 32 * jc + t; const float gl = __expf(cLs[jp]);
#pragma unroll
        for (int jb = 0; jb < 2; ++jb) { f32x16 a = __builtin_amdgcn_mfma_f32_32x32x16_bf16(aKh[jb][0], bB0, Z16, 0, 0, 0); a = __builtin_amdgcn_mfma_f32_32x32x16_bf16(aKh[jb][1], bB1, a, 0, 0, 0);
#pragma unroll
            for (int g = 0; g < 4; ++g) { const int j0 = 32 * jb + 8 * g + 4 * h; float o[4];
#pragma unroll
                for (int e = 0; e < 4; ++e) o[e] = ((j0 + e) == jp ? gl : 0.f) - a[4 * g + e];
                C1_ST4(0, t, j0, o[0], o[1], o[2], o[3]); } }
        C1_FLUSH(0, jc * 2048);
#pragma unroll
        for (int vb = 0; vb < 2; ++vb) { f32x16 a = __builtin_amdgcn_mfma_f32_32x32x16_bf16(aVT[vb][0], bK0, Z16, 0, 0, 0); a = __builtin_amdgcn_mfma_f32_32x32x16_bf16(aVT[vb][1], bK1, a, 0, 0, 0);
            f32x16 s = __builtin_amdgcn_mfma_f32_32x32x16_bf16(aWv[vb][0], bB0, Z16, 0, 0, 0); s = __builtin_amdgcn_mfma_f32_32x32x16_bf16(aWv[vb][1], bB1, s, 0, 0, 0);
#pragma unroll
            for (int g = 0; g < 4; ++g) { const int v0 = 32 * vb + 8 * g + 4 * h; C1_ST4(1, t, v0, a[4 * g] - s[4 * g], a[4 * g + 1] - s[4 * g + 1], a[4 * g + 2] - s[4 * g + 2], a[4 * g + 3] - s[4 * g + 3]); } }
        C1_FLUSH(1, 4096 + jc * 2048); }
    LDS_WAIT(); asm volatile("" ::: "memory");
#undef C1_ROW
#undef C1_PUT
#undef C1_GETA
#undef C1_TR
#undef C1_ST4
#undef C1_FLUSH
}
__device__ __forceinline__ NOPK void c2_phase(Frame& F, const Args& A, int l) {
    const bf16* OPS = (const bf16*)(F.ws + WS_OPS); const bf16* CHB = (const bf16*)(F.ws + WS_CH); bf16* YC = (bf16*)(F.ws + WS_YCAT);
    constexpr int NSLOT = 5, SLOT_B = CH_ELEMS * 2, DEPTH_C = 4, PER_W = 12;
    LAS float* ybuf = (LAS float*)(F.lds + NSLOT * SLOT_B);
    static_assert(NSLOT * SLOT_B + 3 * 8192 <= MISC_OFF, "c2 LDS map");
    const int qi = F.lane & 31, hh = F.lane >> 5, vb32 = 32 * F.wave;
    const f32x16 Z16 = {0.f, 0.f, 0.f, 0.f, 0.f, 0.f, 0.f, 0.f, 0.f, 0.f, 0.f, 0.f, 0.f, 0.f, 0.f, 0.f};
    bf16x8 idn[2];
#pragma unroll
    for (int ks = 0; ks < 2; ++ks) { float f[8];
#pragma unroll
        for (int j = 0; j < 8; ++j) f[j] = (16 * ks + 8 * hh + j == qi) ? 1.0f : 0.f;
        idn[ks] = pack8(f); }
    const int pidx = (F.tid - 128) & 255, st = pidx >> 3, c8 = 8 * (pidx & 7); const bool loader = F.wave >= 6, chain = F.wave < 2;
    for (int bh = F.bid; bh < BATCH * NH; bh += F.G) {
        const int b = bh >> 3, h = bh & 7;
        if (chain) {
            f32x16 S0 = Z16, S1 = Z16;
            LDS_BARRIER();
            for (int c = 0; c <= NCH; ++c) {
                if (c < NCH) {
                    const LAS bf16* sl = (const LAS bf16*)(F.lds + (c % NSLOT) * SLOT_B);
#define C2_GETP(OFF, ROW, ks) ({ const u32x2 lo_ = *(const LAS u32x2*)(sl + (OFF) + (ROW) * 64 + CH_SWZ(ROW, 16 * (ks) + 4 * hh)), hi_ = *(const LAS u32x2*)(sl + (OFF) + (ROW) * 64 + CH_SWZ(ROW, 16 * (ks) + 8 + 4 * hh)); \
                        const u32x4 w_ = {lo_.x, lo_.y, hi_.x, hi_.y}; __builtin_bit_cast(bf16x8, w_); })
#define C2_GETN(OFF, ROW, ks) (*(const LAS bf16x8*)(sl + (OFF) + (ROW) * 64 + CH_SWZ(ROW, vb32 + 16 * (ks) + 8 * hh)))
                    bf16x8 sf[4]; sf[0] = acc_frag(S0, 0); sf[1] = acc_frag(S0, 1); sf[2] = acc_frag(S1, 0); sf[3] = acc_frag(S1, 1);
                    f32x16 Y = Z16, N0 = Z16, N1 = Z16;
#pragma unroll
                    for (int ks = 0; ks < 2; ++ks) { Y = __builtin_amdgcn_mfma_f32_32x32x16_bf16(C2_GETN(10240, qi, ks), idn[ks], Y, 0, 0, 0); N0 = __builtin_amdgcn_mfma_f32_32x32x16_bf16(C2_GETN(4096, qi, ks), idn[ks], N0, 0, 0, 0);
                                                    N1 = __builtin_amdgcn_mfma_f32_32x32x16_bf16(C2_GETN(4096, 32 + qi, ks), idn[ks], N1, 0, 0, 0); }
#pragma unroll
                    for (int ks = 0; ks < 4; ++ks) { Y = __builtin_amdgcn_mfma_f32_32x32x16_bf16(C2_GETP(8192, qi, ks), sf[ks], Y, 0, 0, 0);
                        N0 = __builtin_amdgcn_mfma_f32_32x32x16_bf16(C2_GETP(0, qi, ks), sf[ks], N0, 0, 0, 0); N1 = __builtin_amdgcn_mfma_f32_32x32x16_bf16(C2_GETP(0, 32 + qi, ks), sf[ks], N1, 0, 0, 0); }
                    LAS float* yb = ybuf + (c % 3) * 2048;
#pragma unroll
                    for (int i = 0; i < 16; ++i) { const int row = (i & 3) + 8 * (i >> 2) + 4 * hh; yb[row * 64 + vb32 + qi] = Y[i]; }
                    S0 = N0; S1 = N1;
#undef C2_GETP
#undef C2_GETN
                }
                LDS_BARRIER();
            }
            LDS_BARRIER();
        } else if (loader) {
#define C2_DMA(cidx) do { const bf16* ch_ = CHB + ((size_t)bh * NCH + (cidx)) * CH_ELEMS; LAS unsigned char* sl_ = F.lds + ((cidx) % NSLOT) * SLOT_B; \
            _Pragma("unroll") for (int k_ = 0; k_ < PER_W; ++k_) { const int i_ = (F.wave - 6) + 2 * k_; \
                __builtin_amdgcn_global_load_lds((const unsigned*)(ch_ + i_ * 512 + F.lane * 8), (LAS unsigned*)(sl_ + i_ * 1024), 16, 0, 0); } } while (0)
#pragma unroll 1
            for (int cc = 0; cc < DEPTH_C; ++cc) C2_DMA(cc);
            asm volatile("s_waitcnt vmcnt(36)" ::: "memory");
            LDS_BARRIER();
            for (int c = 0; c <= NCH; ++c) {
                if (c + DEPTH_C < NCH) { C2_DMA(c + DEPTH_C); asm volatile("s_waitcnt vmcnt(36)" ::: "memory"); }
                else if (c + 3 < NCH) asm volatile("s_waitcnt vmcnt(24)" ::: "memory");
                else if (c + 2 < NCH) asm volatile("s_waitcnt vmcnt(12)" ::: "memory");
                else asm volatile("s_waitcnt vmcnt(0)" ::: "memory");
                LDS_BARRIER();
            }
            LDS_BARRIER();
#undef C2_DMA
        } else {
            float plw[8], plb[8]; const float* BON = (const float*)(F.ws + WS_BON);
            ld8f(A.in[I_LNW] + (size_t)l * DR + 64 * h + c8, plw); ld8f(A.in[I_LNB] + (size_t)l * DR + 64 * h + c8, plb);
            u32x4 pv, pg, qv, qg; float pb = 0.f, qb = 0.f;
            LDS_BARRIER();
            for (int c = 0; c <= NCH; ++c) {
                if (c < NCH) { const bf16* op = OPS + ((size_t)bh * SEQ + c * CL) * 448 + (st >> 4) * 7168 + (c8 >> 5) * 512 + (st & 15) * 32 + (c8 & 31);
                    qv = *(const u32x4*)(op + 3 * 1024); qg = *(const u32x4*)(op + 6 * 1024); qb = BON[(size_t)bh * SEQ + c * CL + st]; }
                LDS_BARRIER();
                if (c > 0) {
                    const int cc = c - 1; const LAS float* yb = ybuf + (cc % 3) * 2048;
                    float y[8], v8[8], g8[8]; lds8f(yb + st * 64 + c8, y); unpack8(pv, v8); unpack8(pg, g8);
                    float s_ = 0.f;
#pragma unroll
                    for (int i = 0; i < 8; ++i) s_ += y[i];
                    const float mean = red8(s_) * (1.0f / 64.0f); float q = 0.f;
#pragma unroll
                    for (int i = 0; i < 8; ++i) { y[i] -= mean; q += y[i] * y[i]; }
                    const float rstd = 1.0f / sqrtf(red8(q) * (1.0f / 64.0f) + GN_EPS); const float bon = pb;
#pragma unroll
                    for (int i = 0; i < 8; ++i) y[i] = (y[i] * rstd * plw[i] + plb[i] + bon * v8[i]) * g8[i];
                    *(u32x4*)(YC + ((size_t)b * SEQ + cc * CL + st) * D + 64 * h + c8) = __builtin_bit_cast(u32x4, pack8(y));
                }
                pv = qv; pg = qg; pb = qb;
            }
            LDS_BARRIER();
        }
    }
}
__device__ __forceinline__ NOPK void c1a_phase(Frame& F, const Args& A, int l) {
    if (F.wave < 4) {
        LAS unsigned char* wl = F.lds + F.wave * C1_LDS;
        const int gw = F.bid * 4 + F.wave, NGW = F.G * 4;
        for (int u = gw; u < BATCH * NH * NCH; u += NGW) c1_unit(F, l, u >> 6, u & 63, wl);
    } else {
        attn_waves(F, A, l, F.bid * 4 + (F.wave - 4), F.G * 4);
    }
}

__global__ void __launch_bounds__(512, 2) NOPK mk_fwd(Args args) {
    extern __shared__ __attribute__((aligned(16))) unsigned char lds_raw[];
    Frame F;
    F.lds = (LAS unsigned char*)lds_raw;
    const int wave_s = __builtin_amdgcn_readfirstlane((int)threadIdx.x >> 6);
#define TID_NOW() ({ unsigned m_ = ~0u; asm volatile("" : "+s"(m_)); wave_s * 64 + (int)__builtin_amdgcn_mbcnt_hi(m_, __builtin_amdgcn_mbcnt_lo(m_, 0u)); })
    F.tid = TID_NOW(); F.lane = F.tid & 63; F.wave = wave_s; F.G = gridDim.x; F.bid = blockIdx.x;
    F.out = args.out; F.ws = args.ws;
    volatile LAS unsigned* MISC = (volatile LAS unsigned*)(F.lds + MISC_OFF);
    if (F.tid < 64) MISC[F.tid] = 0u;
    __syncthreads();
    const int lo = args.ph_lo, hi = args.ph_hi;
    unsigned* barw = (unsigned*)(F.ws + WS_CTL) + CW_BAR;
    XcdBarrier bar; bar.bar = barw; bar.x = 0; bar.st = nullptr;
    if (hi - lo > 1) bar = xcd_barrier_post(barw, MISC + 8, F.tid);
#define IN(k) (lo <= (k) && (k) < hi)
#define FRESH() do { F.tid = TID_NOW(); asm volatile("" : "+v"(F.tid)); F.lane = F.tid & 63; F.wave = wave_s; } while (0)
#define SEAM(k) do { if (IN(k) && IN((k) + 1)) { FRESH(); xcd_barrier(bar, F.tid); } } while (0)
constexpr int WGM_IN = 4, WGM_OUT = 8;
#ifndef PROBE_DUP
#define PROBE_DUP -1
#endif
#define SITE(k, ...) do { if (IN(k)) { __VA_ARGS__ if constexpr (PROBE_DUP >= 0) { if (PROBE_DUP == (k)) { __syncthreads(); __VA_ARGS__ } } } } while (0)
#define SITE2(k, code, ...) do { if (IN(k)) { __VA_ARGS__ if constexpr (PROBE_DUP >= 0) { if (PROBE_DUP == (code)) { __syncthreads(); __VA_ARGS__ } } } } while (0)
    SITE(0, FRESH(); p0_prologue(F, args);); SEAM(0);
    for (int l = 0; l < DEPTH; ++l) {
        const int p = 1 + 9 * l;
        SITE(p + 0, FRESH(); if (l == 0) norm_phase<0>(F, args, 0); else norm_phase<1>(F, args, 1);); SEAM(p + 0);
        SITE(p + 1,
            { FRESH(); pg8::Gemm g{(const bf16*)(F.ws + WS_H), (const bf16*)(F.ws + WS_WIN) + (size_t)l * C_IN * D, D}; pg8::StaticOrder<WGM_IN> S; S.init(M, C_IN, F.G, F.bid);
            pg8::EpiBf16 E{(bf16*)(F.ws + WS_Z), C_IN};
            pg8::gemm_phase<pg8::EpiBf16, pg8::StaticOrder<WGM_IN>, false>(F.lds, g, S, E, F.tid); }); SEAM(p + 1);
        SITE(p + 2, FRESH(); prep_phase(F, args, l);); SEAM(p + 2);
        SITE(p + 3, FRESH(); c1a_phase(F, args, l);); SEAM(p + 3);
        SITE(p + 4, FRESH(); c2_phase(F, args, l);); SEAM(p + 4);
        SITE(p + 5,
            { FRESH(); pg8::Gemm g{(const bf16*)(F.ws + WS_YCAT), (const bf16*)(F.ws + WS_WOUT) + (size_t)l * D * D, D}; pg8::StaticOrder<WGM_OUT> S; S.init(M, D, F.G, F.bid);
            pg8::EpiResid E{l == 0 ? args.in[I_X] : F.out, (bf16*)(F.ws + WS_X1), (const float*)(F.ws + WS_MOD) + (size_t)l * 32 * 6144 + 2048};
            pg8::gemm_phase<pg8::EpiResid, pg8::StaticOrder<WGM_OUT>, false>(F.lds, g, S, E, F.tid); }); SEAM(p + 5);
        SITE(p + 6, FRESH(); n2r_phase(F, args, l););
        if constexpr (PROBE_DUP == 6) { if (l == 0 && IN(p + 6)) { xcd_barrier(bar, F.tid); if (F.bid == 0 && F.tid < 32) ((unsigned*)(F.ws + WS_CTL))[CW_CNT + F.tid] = 0u; xcd_barrier(bar, F.tid); FRESH(); n2r_phase(F, args, l); } }
        SEAM(p + 6);
        SITE(p + 7,
            { FRESH(); build_tab(F, l);
            pg8::Gemm g{(const bf16*)(F.ws + WS_H), (const bf16*)(F.ws + WS_W1 + (size_t)l * NE * 2048 * D), D / 2};
            pg8::MoeOrder<8> S; S.init((const LAS int*)(F.lds + TAB_OFF), (const int*)(F.ws + WS_ROWTOK), F.G, F.bid, D);
            pg8::EpiSwiglu E{F.ws + WS_ACT, args.in[I_B1] + (size_t)l * NE * 2048};
            pg8::gemm_phase<pg8::EpiSwiglu, pg8::MoeOrder<8>, true, true>(F.lds, g, S, E, F.tid); }); SEAM(p + 7);
        SITE(p + 8,
            { FRESH(); build_tab(F, l);
            pg8::Gemm g{(const bf16*)(F.ws + WS_ACT), (const bf16*)(F.ws + WS_W2 + (size_t)l * NE * D * FF), FF / 2};
            pg8::MoeOrder<4, true> S; S.init((const LAS int*)(F.lds + TAB_OFF), (const int*)(F.ws + WS_ROWTOK), F.G, F.bid, FF);
            pg8::EpiY E{F.ws + WS_Y, args.in[I_B2] + (size_t)l * NE * D};
            pg8::gemm_phase<pg8::EpiY, pg8::MoeOrder<4, true>, true, true>(F.lds, g, S, E, F.tid); }); SEAM(p + 8);
    }
    SITE(19, FRESH(); norm_phase<2>(F, args, 1););
#undef IN
#undef SEAM
}

extern "C" void kernel_launch(void* const* d_in, const int* in_sizes, int n_in, void* d_out, int out_size, void* d_ws, size_t ws_size, hipStream_t stream) {
    static int grid = 0;
    if (grid == 0) {
        if (n_in != N_IN || in_sizes[0] != M * D || out_size != M * D || ws_size < WS_END) { fprintf(stderr, "kernel_launch: unexpected shapes (n_in %d, in0 %d, out %d, ws %zu)\n", n_in, n_in > 0 ? in_sizes[0] : -1, out_size, ws_size); grid = -1; return; }
        int dev = 0, cus = 0, per_cu = 0;
        if (hipGetDevice(&dev) != hipSuccess || hipDeviceGetAttribute(&cus, hipDeviceAttributeMultiprocessorCount, dev) != hipSuccess) { grid = -1; return; }
        if (hipFuncSetAttribute((const void*)mk_fwd, hipFuncAttributeMaxDynamicSharedMemorySize, LDS_BYTES) != hipSuccess) { fprintf(stderr, "kernel_launch: hipFuncSetAttribute failed\n"); grid = -1; return; }
        if (hipOccupancyMaxActiveBlocksPerMultiprocessor(&per_cu, (const void*)mk_fwd, 512, LDS_BYTES) != hipSuccess || per_cu < 1) fprintf(stderr, "kernel_launch: occupancy query says %d\n", per_cu);
        (void)hipGetLastError();
        grid = cus;
    }
    if (grid < 0) return;
    (void)hipMemsetAsync((char*)d_ws + WS_CTL, 0, CTL_ZERO_BYTES, stream);
    Args a{};
    for (int i = 0; i < N_IN; ++i) a.in[i] = (const float*)d_in[i];
    a.out = (float*)d_out; a.ws = (unsigned char*)d_ws;
#if MK_N_LAUNCHES == 1
    a.ph_lo = 0; a.ph_hi = NPH;
    hipLaunchKernelGGL(mk_fwd, dim3(grid), dim3(512), LDS_BYTES, stream, a);
#else
    for (int ph = 0; ph < NPH; ++ph) { a.ph_lo = ph; a.ph_hi = ph + 1; hipLaunchKernelGGL(mk_fwd, dim3(grid), dim3(512), LDS_BYTES, stream, a); }
#endif
}
```

```cpp
#include <hip/hip_runtime.h>
#include <cstdio>
#include <cstdint>

#ifndef MK_N_LAUNCHES
#define MK_N_LAUNCHES 1
#endif

#define NOPK __attribute__((target("no-packed-fp32-ops")))
#define __uint_as_float(x) __builtin_bit_cast(float, (unsigned)(x))
#define __float_as_uint(x) __builtin_bit_cast(unsigned, (float)(x))
#define __float_as_int(x) __builtin_bit_cast(int, (float)(x))
#define __int_as_float(x) __builtin_bit_cast(float, (int)(x))
#define __syncthreads() do { __builtin_amdgcn_fence(__ATOMIC_RELEASE, "workgroup"); __builtin_amdgcn_s_barrier(); __builtin_amdgcn_fence(__ATOMIC_ACQUIRE, "workgroup"); } while (0)
#define __all(p) (__builtin_amdgcn_ballot_w64(!(p)) == 0ull)
#define atomicAdd(p, v) __hip_atomic_fetch_add((p), (v), __ATOMIC_RELAXED, __HIP_MEMORY_SCOPE_AGENT)
#define __shfl_xor(v, m) shfl_xor_f32((v), (m))
#define GAS __attribute__((address_space(1)))
#define LAS __attribute__((address_space(3)))
typedef unsigned short bf16;
typedef short bf16x8 __attribute__((ext_vector_type(8)));
typedef float f32x2 __attribute__((ext_vector_type(2)));
typedef float f32x4 __attribute__((ext_vector_type(4)));
typedef float f32x16 __attribute__((ext_vector_type(16)));
typedef unsigned u32x2 __attribute__((ext_vector_type(2)));
typedef unsigned u32x4 __attribute__((ext_vector_type(4)));
typedef int i32x4 __attribute__((ext_vector_type(4)));
typedef int i32x8 __attribute__((ext_vector_type(8)));
typedef short s16x4 __attribute__((ext_vector_type(4)));

constexpr int D = 1024, BATCH = 32, SEQ = 2048, M = BATCH * SEQ, DEPTH = 2;
constexpr int HD = 64, DR = 512, NH = 8;
constexpr int C_RWKV = 1792, C_IN = 3328;
constexpr int NE = 32, FF = 1024;
constexpr int ECAP = 65536;
constexpr int NROWS_MAX = M * 4 + NE * 256;
constexpr int NPH = 20;
constexpr float NORM_EPS = 1e-6f, GN_EPS = 1e-5f * 64.f;
constexpr float SB_EXIT = -30.f;

enum { I_X = 0, I_C, I_N1G, I_N2G, I_ADAW, I_ADAB, I_WIN, I_MU, I_DW0, I_DUP, I_IA0, I_IUP, I_GUP, I_KK, I_KA, I_RK, I_LNW, I_LNB, I_VRD, I_VRU, I_VRB,
       I_QG, I_KG, I_SBG, I_WOUT, I_RW, I_RB, I_W1, I_B1, I_W2, I_B2, N_IN };

constexpr size_t MiB = 1u << 20;
constexpr size_t WS_CTL = 0, CTL_ZERO_BYTES = 128 * 1024;
constexpr size_t WS_MOD = 1 * MiB;
constexpr size_t WS_LORA = 3 * MiB;
constexpr size_t LORA_STRIDE = 512 * 1024;
constexpr size_t LO_DUP = 0, LO_IUP = 65536, LO_GUP = 131072, LO_VRD = 262144, LO_VRU = 294912, LO_RWS = 327680;
constexpr size_t WS_WOUT = 4 * MiB;
constexpr size_t WS_WIN = 8 * MiB;
constexpr size_t WS_W1 = 22 * MiB;
constexpr size_t WS_W2 = 278 * MiB;
constexpr size_t WS_VFIRST = 406 * MiB;
constexpr size_t WS_ROWTOK = 470 * MiB;
constexpr size_t WS_TOKSLOT = 478 * MiB;
constexpr size_t WS_TOKGATE = 479 * MiB;
constexpr size_t WS_BON = WS_TOKSLOT;
constexpr size_t WS_H = 480 * MiB;
constexpr size_t WS_T = 608 * MiB;
constexpr size_t WS_Z = WS_T;
constexpr size_t WS_OPS = WS_T + 416 * MiB;
constexpr size_t WS_QN = WS_T + 864 * MiB;
constexpr size_t WS_KN = WS_T + 928 * MiB;
constexpr size_t WS_VF = WS_T + 992 * MiB;
constexpr size_t WS_YCAT = WS_T + 1056 * MiB;
constexpr size_t WS_ACT = WS_T;
constexpr size_t WS_Y = WS_T + 528 * MiB;
constexpr size_t WS_X1 = WS_T + 272 * MiB;
constexpr size_t WS_END = WS_T + 1184 * MiB;
static_assert((size_t)NROWS_MAX * 2048 <= 528 * MiB, "act/y buffers");
static_assert((size_t)NROWS_MAX * 1024 <= 272 * MiB, "e4m3 act rows end below x1");
constexpr int CW_TMO = 0, CW_BAR = 4096, CW_CNT = 16384;

constexpr int RING_BYTES = 131072;
constexpr int XTRA_OFF = RING_BYTES, XTRA_BYTES = 32512;
constexpr int MISC_OFF = XTRA_OFF + XTRA_BYTES;
constexpr int LDS_BYTES = MISC_OFF + 256;
constexpr int TAB_OFF = XTRA_OFF;
constexpr int GOFF_OFF = XTRA_OFF + 4096;

__device__ __forceinline__ NOPK float shfl_xor_f32(float v, int m) { int lane = (int)__builtin_amdgcn_mbcnt_hi(~0u, __builtin_amdgcn_mbcnt_lo(~0u, 0u)); asm volatile("" : "+v"(lane));     return __builtin_bit_cast(float, __builtin_amdgcn_ds_bpermute((lane ^ m) << 2, __builtin_bit_cast(int, v))); }
typedef __bf16 bf16v2_t __attribute__((ext_vector_type(2)));
__device__ __forceinline__ NOPK unsigned cvt_pk_bf16(float lo, float hi) { const f32x2 v = {lo, hi}; return __builtin_bit_cast(unsigned, __builtin_convertvector(v, bf16v2_t)); }
__device__ __forceinline__ NOPK float bflo(unsigned w) { return __uint_as_float(w << 16); }
__device__ __forceinline__ NOPK float bfhi(unsigned w) { return __uint_as_float(w & 0xffff0000u); }
__device__ __forceinline__ NOPK float wave_sum(float v) {
#pragma unroll
    for (int o = 1; o < 64; o <<= 1) v += __shfl_xor(v, o);
    return v;
}
template <int CTRL> __device__ __forceinline__ NOPK float dpp_add(float x) { return x + __int_as_float(__builtin_amdgcn_update_dpp(0, __float_as_int(x), CTRL, 0xf, 0xf, true)); }
__device__ __forceinline__ NOPK float red4(float x) { x = dpp_add<0xB1>(x); x = dpp_add<0x4E>(x); return x; }
__device__ __forceinline__ NOPK float red8(float x) { x = red4(x); return dpp_add<0x141>(x); }
__device__ __forceinline__ NOPK float red16(float x) { x = red8(x); return dpp_add<0x140>(x); }
__device__ __forceinline__ NOPK float fsigmoid(float x) { return __builtin_amdgcn_rcpf(1.0f + __builtin_amdgcn_exp2f(-1.44269504f * x)); }
__device__ __forceinline__ NOPK float ftanh(float x) { const float t = __builtin_amdgcn_exp2f(-2.88539008f * fabsf(x)); const float r = (1.0f - t) * __builtin_amdgcn_rcpf(1.0f + t); return x < 0.f ? -r : r; }
__device__ __forceinline__ NOPK float fsoftplus(float x) { return fmaxf(x, 0.f) + 0.69314718f * __builtin_amdgcn_logf(1.0f + __builtin_amdgcn_exp2f(-1.44269504f * fabsf(x))); }
__device__ __forceinline__ NOPK unsigned pk_fp8x4(float a, float b, float c, float d) { int w = 0; w = __builtin_amdgcn_cvt_pk_fp8_f32(a, b, w, false); w = __builtin_amdgcn_cvt_pk_fp8_f32(c, d, w, true); return (unsigned)w; }
constexpr float W8_SCALE = 64.0f; constexpr int W8_EXP = 127 - 3, A8_EXP = 127 - 3;
constexpr float Y8_SCALE = 16.0f;
#define LDS_WAIT() asm volatile("s_waitcnt lgkmcnt(0)" ::: "memory")
#define LDS_IADD(p, v) ((void)__hip_atomic_fetch_add((p), (v), __ATOMIC_RELAXED, __HIP_MEMORY_SCOPE_WORKGROUP))
#define LDS_BARRIER() do { asm volatile("s_waitcnt lgkmcnt(0)" ::: "memory"); __builtin_amdgcn_s_barrier(); asm volatile("" ::: "memory"); } while (0)
#define VM_WAIT() asm volatile("s_waitcnt vmcnt(0)" ::: "memory")

#define XB_TMO      128
#define XB_XCNT(j)  (256  + 64 * (j))
#define XB_XSUB(j)  (1280 + 64 * (j))
#define XB_XGEN(j)  (2304 + 64 * (j))
#define XB_TOP      3328
#define XB_TOPGEN   3392
#define XCD_BAR_WORDS 3456
#define XB_SPIN_CAP (1u << 18)
__device__ __forceinline__ NOPK unsigned xb_ld(unsigned* p)              { return __hip_atomic_load(p, __ATOMIC_RELAXED, __HIP_MEMORY_SCOPE_AGENT); }
__device__ __forceinline__ NOPK unsigned xb_add(unsigned* p, unsigned v) { return __hip_atomic_fetch_add(p, v, __ATOMIC_RELAXED, __HIP_MEMORY_SCOPE_AGENT); }
__device__ __forceinline__ NOPK unsigned xb_xcc_id() { return (unsigned)__builtin_amdgcn_s_getreg((3 << 11) | 20) & 0xFu; }
#define XB_SPIN(cond, bar) do { unsigned _sp = 0; while (cond) { __builtin_amdgcn_s_sleep(1); \
    if ((++_sp & 255u) == 0u) { if (xb_ld(&(bar)[XB_TMO])) break; if (_sp > XB_SPIN_CAP) { atomicAdd(&(bar)[XB_TMO], 1u); break; } } } } while (0)
struct XcdBarrier { unsigned* bar; unsigned x; volatile LAS unsigned* st; };
__device__ __forceinline__ NOPK XcdBarrier xcd_barrier_post(unsigned* bar, volatile LAS unsigned* st, int tid) {
    XcdBarrier b; b.bar = bar; b.x = xb_xcc_id(); b.st = st;
    if (tid == 0) (void)xb_add(&bar[XB_XCNT(b.x)], 1u);
    return b;
}
__device__ __forceinline__ NOPK void xcd_barrier_complete(unsigned* bar, unsigned x, unsigned& nloc, unsigned& nx) {
    const unsigned G = gridDim.x * gridDim.y * gridDim.z;
    unsigned sum, cnt, mine, sp = 0u;
    for (;;) {
        sum = 0u; cnt = 0u; mine = 0u;
#pragma unroll
        for (unsigned j = 0; j < 16; ++j) { const unsigned c = xb_ld(&bar[XB_XCNT(j)]); sum += c; cnt += (c > 0u) ? 1u : 0u; mine = (j == x) ? c : mine; }
        if (sum == G) break;
        __builtin_amdgcn_s_sleep(1);
        if ((++sp & 255u) == 0u) { if (xb_ld(&bar[XB_TMO])) break; if (sp > XB_SPIN_CAP) { atomicAdd(&bar[XB_TMO], 1u); break; } }
    }
    nloc = mine > 0u ? mine : 1u; nx = cnt > 0u ? cnt : 1u;
}
__device__ __forceinline__ NOPK void xcd_barrier(const XcdBarrier& b, int tid) {
    asm volatile("s_waitcnt vmcnt(0)" ::: "memory");
    __syncthreads();
    if (tid == 0) {
        unsigned* bar = b.bar;
        __builtin_amdgcn_s_waitcnt(0);
        unsigned nloc = b.st[0], nx = b.st[1];
        if (nloc == 0u) { xcd_barrier_complete(bar, b.x, nloc, nx); b.st[0] = nloc; b.st[1] = nx; }
        const unsigned old = xb_add(&bar[XB_XSUB(b.x)], 1u);
        const unsigned gen = old / nloc;
        if (old + 1u == (gen + 1u) * nloc) {
            __builtin_amdgcn_fence(__ATOMIC_RELEASE, "agent");
            asm volatile("s_waitcnt vmcnt(0)" ::: "memory");
            const unsigned og = xb_add(&bar[XB_TOP], 1u);
            const unsigned tg = og / nx;
            if (og + 1u == (tg + 1u) * nx) xb_add(&bar[XB_TOPGEN], 1u);
            else XB_SPIN(xb_ld(&bar[XB_TOPGEN]) == tg, bar);
            __builtin_amdgcn_fence(__ATOMIC_ACQUIRE, "agent");
            xb_add(&bar[XB_XGEN(b.x)], 1u);
            asm volatile("s_waitcnt vmcnt(0)" ::: "memory");
        } else {
            XB_SPIN(xb_ld(&bar[XB_XGEN(b.x)]) == gen, bar);
            __builtin_amdgcn_fence(__ATOMIC_ACQUIRE, "agent");
            asm volatile("s_waitcnt vmcnt(0)" ::: "memory");
        }
    }
    __syncthreads();
}

namespace pg8 {
constexpr int BM = 256, BK = 64, HALF = 128, HTB = HALF * BK * 2, STAGE_BYTES = 8 * HTB, NXCD = 8;
__host__ __device__ __forceinline__ NOPK int lds_byte(int r, int c) { const int st = (r >> 4) * 2 + (c >> 5), rr = r & 15, cc = c & 31, ob = rr * 64 + cc * 2; return st * 1024 + (ob ^ (((ob >> 9) & 1) << 5)); }
__host__ __device__ __forceinline__ NOPK void stage_rc(int b, int& R, int& C) { const int st = b / 1024, sb = b % 1024, swz = sb ^ (((sb >> 9) & 1) << 5); R = (st >> 1) * 16 + swz / 64; C = (st & 1) * 32 + (swz % 64) / 2; }
__host__ __device__ __forceinline__ NOPK int perm32(int rho) { const int n = rho >> 4, i = rho & 15; return 8 * (i >> 2) + 4 * n + (i & 3); }
__host__ __device__ __forceinline__ int perm64(int R) { const int wc = (R >> 5) & 3, rho = R & 31, n = rho >> 4, fq = (rho & 15) >> 2, e = rho & 3; return 64 * wc + 8 * fq + 4 * n + e; }
__host__ __device__ __forceinline__ int perm256(int R) { const int wc = (R >> 5) & 3, rho = R & 31, n = rho >> 4, fq = (rho & 15) >> 2, e = rho & 3; return 64 * wc + 16 * fq + 4 * n + e; }
struct Unit { int pm, pn, e; };
struct Gemm { const bf16* A; const bf16* Bt; int K; };

template <int WGM> struct StaticOrder {
    int nM, nN, nwg, G, c;
    __device__ __forceinline__ NOPK void init(int M_, int N_, int G_, int c_) { nM = M_ / BM; nN = N_ / BM; nwg = nM * nN; G = G_; c = c_; }
    __device__ __forceinline__ NOPK bool next(int i, Unit& u) const {
        const long L = (long)i * G + c; if (L >= nwg) return false;
        int wgid = (int)L; { const int q = nwg / NXCD, r = nwg % NXCD, xcd = wgid % NXCD, off = wgid / NXCD; wgid = (xcd < r ? xcd * (q + 1) : r * (q + 1) + (xcd - r) * q) + off; }
        const int nig = WGM * nN, gid = wgid / nig, fm = gid * WGM, gsz = (nM - fm) < WGM ? (nM - fm) : WGM;
        u.pm = fm + ((wgid % nig) % gsz); u.pn = (wgid % nig) / gsz; u.e = 0; return true;
    }
    __device__ __forceinline__ NOPK unsigned row_off(const Unit&, int) const { return 0u; }
};
template <int NPN, bool IDENT = false> struct MoeOrder {
    const LAS int* tab;
    const int* rowtok;
    int G, c, T, K2;
    __device__ __forceinline__ NOPK void init(const LAS int* tab_, const int* rowtok_, int G_, int c_, int K2_) { tab = tab_; rowtok = rowtok_; G = G_; c = c_; T = tab_[32]; K2 = K2_; }
    __device__ __forceinline__ NOPK bool next(int i, Unit& u) const {
        constexpr int TPR = 256 / NPN, TPX = TPR / 8;
        int tile, pnl;
        if (G == 256) { const int r = c >> 3; tile = i * TPR + (c & 7) * TPX + r / NPN; pnl = r % NPN; }
        else { const long L = (long)i * G + c; tile = (int)(L / NPN); pnl = (int)(L % NPN); }
        if (tile >= T) return false;
        const int lo = ((const LAS unsigned char*)tab)[1024 + tile];
        u.pm = tile; u.e = lo; u.pn = lo * NPN + pnl; return true;
    }
    __device__ __forceinline__ NOPK unsigned row_off(const Unit& u, int r) const {
        if constexpr (IDENT) return (unsigned)(u.pm * 256 + r) * (unsigned)K2;
        const int slot = (u.pm - tab[u.e]) * 256 + r; const int cnt = tab[64 + u.e];
        const int tok = slot < cnt ? rowtok[u.e * ECAP + slot] : 0;
        return (unsigned)tok * (unsigned)K2;
    }
};

template <class Epi, class Sched, bool GATHER, bool FP8 = false>
__device__ __forceinline__ NOPK void gemm_phase(LAS unsigned char* lds, const Gemm g, const Sched& S, const Epi& E, int tid_in) {
    int tid_ = tid_in; asm volatile("" : "+v"(tid_));
    const int tid = tid_, wid = __builtin_amdgcn_readfirstlane(tid >> 6), lane = tid & 63, wr = wid >> 2, wc = wid & 3, fr = lane & 15, fq = lane >> 4;
    int K_ = g.K; asm volatile("" : "+s"(K_));
    const int K = K_, nt = K / BK;
    unsigned voffA[2], voffB[2]; int RA[2];
#pragma unroll
    for (int i = 0; i < 2; ++i) { int R, C; stage_rc(tid * 16 + i * 8192, R, C); const int Rb = Epi::PERM == 2 ? perm256(R) : (Epi::PERM == 3 ? perm64(R) : (Epi::PERM ? ((R & ~31) + perm32(R & 31)) : R));
        RA[i] = R; voffA[i] = GATHER ? 0u : (unsigned)(R * K + C) * 2u; voffB[i] = (unsigned)(Rb * K + C) * 2u; }
    const unsigned kstep = (unsigned)(BK * 2);
    const unsigned hstep = (unsigned)HALF * (unsigned)K * 2u;
    const unsigned tstep = 2u * hstep;
    const unsigned hstepB = (Epi::PERM == 2) ? 8u * (unsigned)K * 2u : ((Epi::PERM == 3) ? 32u * (unsigned)K * 2u : hstep);
    const unsigned ldsw = (unsigned)wid * 1024u;
    const int aoff = lds_byte(wr * 64 + fr, fq * 8), boff = lds_byte(wc * 32 + fr, fq * 8);
    const __amdgpu_buffer_rsrc_t rA = __builtin_amdgcn_make_buffer_rsrc((void*)g.A, (short)0, (int)0xffffffffu, 0x00020000);
    const __amdgpu_buffer_rsrc_t rB = __builtin_amdgcn_make_buffer_rsrc((void*)g.Bt, (short)0, (int)0xffffffffu, 0x00020000);
#define PG8_SA(b, h) (((b) * 2 + (h)) * HTB)
#define PG8_SB(b, h) ((4 + (b) * 2 + (h)) * HTB)
#define PG8_STG(rs, bufoff, soff, voff) do { _Pragma("unroll") for (int _i = 0; _i < 2; ++_i) \
        __builtin_amdgcn_raw_ptr_buffer_load_lds(rs, (LAS unsigned*)(lds + (bufoff) + ldsw + _i * 8192), 16, (int)(voff)[_i], (int)(soff), 0, 0); } while (0)
#define PG8_STAGE_B(bufoff, soff) PG8_STG(rB, bufoff, soff, voffB)
#define PG8_STAGE_A(bufoff, h, kb) do { if constexpr (GATHER) { PG8_STG(rA, bufoff, kb, gA[h]); } else { PG8_STG(rA, bufoff, oA + (unsigned)(h) * hstep + (kb), voffA); } } while (0)
#define PG8_LDA(dst, b, h) do { _Pragma("unroll") for (int m = 0; m < 4; ++m) _Pragma("unroll") for (int k = 0; k < 2; ++k) dst[m][k] = *(const LAS bf16x8*)(lds + PG8_SA(b, h) + aoff + m * 2048 + k * 1024); } while (0)
#define PG8_LDB(dst, b, h) do { _Pragma("unroll") for (int n = 0; n < 2; ++n) _Pragma("unroll") for (int k = 0; k < 2; ++k) dst[n][k] = *(const LAS bf16x8*)(lds + PG8_SB(b, h) + boff + n * 2048 + k * 1024); } while (0)
#define PG8_CAT(x, y) __builtin_shufflevector(__builtin_bit_cast(i32x4, x), __builtin_bit_cast(i32x4, y), 0, 1, 2, 3, 4, 5, 6, 7)
#define PG8_MMA(ai, bj, At, Bt) do { __builtin_amdgcn_s_setprio(1); _Pragma("unroll") for (int m = 0; m < 4; ++m) _Pragma("unroll") for (int n = 0; n < 2; ++n) { \
        if constexpr (FP8) acc[ai][bj][m][n] = __builtin_amdgcn_mfma_scale_f32_16x16x128_f8f6f4(PG8_CAT(Bt[n][0], Bt[n][1]), PG8_CAT(At[m][0], At[m][1]), acc[ai][bj][m][n], 0, 0, 0, (Epi::PERM == 2 ? W8_EXP + 2 : W8_EXP), 0, (Epi::PERM == 2 ? A8_EXP + 2 : A8_EXP)); \
        else { _Pragma("unroll") for (int k = 0; k < 2; ++k) acc[ai][bj][m][n] = __builtin_amdgcn_mfma_f32_16x16x32_bf16(Bt[n][k], At[m][k], acc[ai][bj][m][n], 0, 0, 0); } } __builtin_amdgcn_s_setprio(0); } while (0)
#define PG8_WAIT_V(n) asm volatile("s_waitcnt vmcnt(" #n ")" ::: "memory")
#define PG8_WAIT_V8E() do { if (firstk) { if constexpr (Epi::NS == 8) asm volatile("s_waitcnt vmcnt(16)" ::: "memory"); else if constexpr (Epi::NS == 16) asm volatile("s_waitcnt vmcnt(24)" ::: "memory"); \
        else asm volatile("s_waitcnt vmcnt(40)" ::: "memory"); } else asm volatile("s_waitcnt vmcnt(8)" ::: "memory"); } while (0)
#define PG8_WAIT_L(n) asm volatile("s_waitcnt lgkmcnt(" #n ")" ::: "memory")
#define PG8_BAR __builtin_amdgcn_s_barrier()
#define PG8_SCHED __builtin_amdgcn_sched_barrier(0)
    Unit cur, nxt; int ui = 0;
    if (!S.next(0, cur)) return;
    f32x4 acc[2][2][4][2];
    { float z_ = 0.f; asm volatile("" : "+v"(z_));
#pragma unroll
    for (int a = 0; a < 2; ++a)
#pragma unroll
        for (int b = 0; b < 2; ++b)
#pragma unroll
            for (int m = 0; m < 4; ++m)
#pragma unroll
                for (int n = 0; n < 2; ++n) acc[a][b][m][n] = (f32x4){z_, z_, z_, z_}; }
    bf16x8 At[4][2], B0[2][2], B1[2][2];
    unsigned oA = GATHER ? 0u : (unsigned)cur.pm * tstep, oB = (unsigned)cur.pn * tstep;
    unsigned gA[2][2];
    if constexpr (GATHER) {
#pragma unroll
        for (int h = 0; h < 2; ++h)
#pragma unroll
            for (int i = 0; i < 2; ++i) { int R_, C_; stage_rc(tid * 16 + i * 8192, R_, C_); gA[h][i] = S.row_off(cur, h * HALF + R_) + (unsigned)(C_ * 2); }
    } else { gA[0][0] = gA[0][1] = gA[1][0] = gA[1][1] = 0u; }
    PG8_STAGE_B(PG8_SB(0, 0), oB); PG8_STAGE_B(PG8_SB(0, 1), oB + hstepB); PG8_STAGE_A(PG8_SA(0, 0), 0, 0u); PG8_STAGE_A(PG8_SA(0, 1), 1, 0u);
    if (wr == 1) PG8_BAR;
    PG8_WAIT_V(2); PG8_BAR;
    PG8_STAGE_B(PG8_SB(1, 0), oB + kstep); PG8_STAGE_A(PG8_SA(1, 0), 0, kstep); PG8_STAGE_B(PG8_SB(1, 1), oB + hstepB + kstep);
    PG8_WAIT_V(6); PG8_BAR;
    for (;;) {
        const bool has_next = S.next(ui + 1, nxt);
        const unsigned noA = (has_next && !GATHER) ? (unsigned)nxt.pm * tstep : oA, noB = has_next ? (unsigned)nxt.pn * tstep : oB;
#pragma nounroll
        for (int t = 0; t < nt; t += 2) {
            const bool last = (t == nt - 2), firstk = (t == 0) && (ui > 0);
            const unsigned b2 = last ? noB : oB + (unsigned)(t + 2) * kstep, b3 = b2 + kstep;
            const unsigned k2 = last ? 0u : (unsigned)(t + 2) * kstep;
            unsigned nA_[2][2];
            if constexpr (GATHER) {
                if (t == 0 && has_next) {
                    int tq_ = (int)__builtin_amdgcn_mbcnt_hi(~0u, __builtin_amdgcn_mbcnt_lo(~0u, 0u)); asm volatile("" : "+v"(tq_)); tq_ += wid * 64;
                    u32x4 pk_;
#pragma unroll
                    for (int h = 0; h < 2; ++h)
#pragma unroll
                        for (int i = 0; i < 2; ++i) { int R_, C_; stage_rc(tq_ * 16 + i * 8192, R_, C_); pk_[h * 2 + i] = S.row_off(nxt, h * HALF + R_) + (unsigned)(C_ * 2); }
                    *(LAS u32x4*)(lds + GOFF_OFF + tq_ * 16) = pk_; }
                if (last && has_next) {
                    int tq_ = (int)__builtin_amdgcn_mbcnt_hi(~0u, __builtin_amdgcn_mbcnt_lo(~0u, 0u)); asm volatile("" : "+v"(tq_)); tq_ += wid * 64;
                    const u32x4 pk_ = *(const LAS u32x4*)(lds + GOFF_OFF + tq_ * 16);
                    nA_[0][0] = pk_.x; nA_[0][1] = pk_.y; nA_[1][0] = pk_.z; nA_[1][1] = pk_.w; } }
            PG8_LDB(B0, 0, 0); PG8_LDB(B1, 0, 1); PG8_SCHED; PG8_LDA(At, 0, 0); PG8_STAGE_A(PG8_SA(1, 1), 1, (unsigned)(t + 1) * kstep);
            if (last) { if constexpr (GATHER) { if (has_next) {
#pragma unroll
                for (int h = 0; h < 2; ++h)
#pragma unroll
                    for (int i = 0; i < 2; ++i) gA[h][i] = nA_[h][i]; } } else { oA = noA; } }
            PG8_WAIT_V8E(); PG8_WAIT_L(0); PG8_BAR; PG8_MMA(0, 0, At, B0); PG8_MMA(0, 1, At, B1); PG8_BAR; PG8_SCHED;
            PG8_LDA(At, 0, 1); PG8_STAGE_B(PG8_SB(0, 0), b2); PG8_STAGE_B(PG8_SB(0, 1), b2 + hstepB); PG8_STAGE_A(PG8_SA(0, 0), 0, k2);
            PG8_WAIT_V8E(); PG8_WAIT_L(0); PG8_BAR; PG8_MMA(1, 0, At, B0); PG8_MMA(1, 1, At, B1); PG8_BAR; PG8_SCHED;
            PG8_LDB(B0, 1, 0); PG8_LDB(B1, 1, 1); PG8_SCHED; PG8_LDA(At, 1, 0); PG8_STAGE_A(PG8_SA(0, 1), 1, k2);
            PG8_WAIT_V(8); PG8_WAIT_L(0); PG8_BAR; PG8_MMA(0, 0, At, B0); PG8_MMA(0, 1, At, B1); PG8_BAR; PG8_SCHED;
            PG8_LDA(At, 1, 1); PG8_STAGE_B(PG8_SB(1, 0), b3); PG8_STAGE_B(PG8_SB(1, 1), b3 + hstepB); PG8_STAGE_A(PG8_SA(1, 0), 0, k2 + kstep);
            PG8_WAIT_V(8); PG8_WAIT_L(0); PG8_BAR; PG8_MMA(1, 0, At, B0); PG8_MMA(1, 1, At, B1); PG8_BAR; PG8_SCHED;
        }
        if (wr == 0) PG8_BAR;
        { int ln_ = (int)__builtin_amdgcn_mbcnt_hi(~0u, __builtin_amdgcn_mbcnt_lo(~0u, 0u)); asm volatile("" : "+v"(ln_));
          E(acc, cur, wr, wc, ln_ & 15, ln_ >> 4); }
        if (!has_next) break;
        { float z_ = 0.f; asm volatile("" : "+v"(z_));
#pragma unroll
        for (int a = 0; a < 2; ++a)
#pragma unroll
            for (int b = 0; b < 2; ++b)
#pragma unroll
                for (int m = 0; m < 4; ++m)
#pragma unroll
                    for (int n = 0; n < 2; ++n) acc[a][b][m][n] = (f32x4){z_, z_, z_, z_}; }
        cur = nxt; oB = noB; ++ui;
        if (wr == 1) PG8_BAR;
    }
    PG8_WAIT_V(0);
    PG8_BAR;
#undef PG8_SA
#undef PG8_SB
#undef PG8_STG
#undef PG8_STAGE_B
#undef PG8_STAGE_A
#undef PG8_LDA
#undef PG8_LDB
#undef PG8_MMA
#undef PG8_CAT
#undef PG8_WAIT_V
#undef PG8_WAIT_V8E
#undef PG8_WAIT_L
#undef PG8_BAR
#undef PG8_SCHED
}

struct EpiBf16 {
    static constexpr int PERM = 3; static constexpr int NS = 16;
    bf16* O; int ldc;
    __device__ __forceinline__ NOPK void operator()(const f32x4 (&acc)[2][2][4][2], const Unit& u, int wr, int wc, int fr, int fq) const {
        const int row0 = u.pm * BM + wr * 64 + fr, col0 = u.pn * BM + wc * 64 + 8 * fq;
#pragma unroll
        for (int ai = 0; ai < 2; ++ai)
#pragma unroll
            for (int m = 0; m < 4; ++m) { bf16* rowp = O + (size_t)(row0 + ai * HALF + m * 16) * ldc + col0;
#pragma unroll
                for (int bj = 0; bj < 2; ++bj) { const f32x4 v0 = acc[ai][bj][m][0], v1 = acc[ai][bj][m][1];
                    u32x4 w; w.x = cvt_pk_bf16(v0[0], v0[1]); w.y = cvt_pk_bf16(v0[2], v0[3]); w.z = cvt_pk_bf16(v1[0], v1[1]); w.w = cvt_pk_bf16(v1[2], v1[3]);
                    *(u32x4*)(rowp + bj * 32) = w; } }
    }
};
struct EpiResid {
    static constexpr bool PERM = true; static constexpr int NS = 16;
    const float* base; bf16* out; const float* gate;
    __device__ __forceinline__ NOPK void operator()(const f32x4 (&acc)[2][2][4][2], const Unit& u, int wr, int wc, int fr, int fq) const {
        const int row0 = u.pm * BM + wr * 64 + fr, col0 = u.pn * BM + wc * 32 + 8 * fq; const int b = (u.pm * BM) / SEQ;
        f32x4 gv[2][2];
#pragma unroll
        for (int bj = 0; bj < 2; ++bj)
#pragma unroll
            for (int n = 0; n < 2; ++n) gv[bj][n] = *(const f32x4*)(gate + (size_t)b * 6144 + col0 + bj * HALF + 4 * n);
#pragma unroll
        for (int ai = 0; ai < 2; ++ai)
#pragma unroll
            for (int m = 0; m < 4; ++m) { const size_t off = (size_t)(row0 + ai * HALF + m * 16) * D + col0;
#pragma unroll
                for (int bj = 0; bj < 2; ++bj) { const f32x4 b0 = *(const f32x4*)(base + off + bj * HALF), b1 = *(const f32x4*)(base + off + bj * HALF + 4);
                    const f32x4 o0 = b0 + gv[bj][0] * acc[ai][bj][m][0], o1 = b1 + gv[bj][1] * acc[ai][bj][m][1];
                    u32x4 w; w.x = cvt_pk_bf16(o0[0], o0[1]); w.y = cvt_pk_bf16(o0[2], o0[3]); w.z = cvt_pk_bf16(o1[0], o1[1]); w.w = cvt_pk_bf16(o1[2], o1[3]);
                    *(u32x4*)(out + off + bj * HALF) = w; } }
    }
};
struct EpiSwiglu {
    static constexpr bool PERM = true; static constexpr int NS = 8;
    unsigned char* O; const float* b1;
    __device__ __forceinline__ NOPK void operator()(const f32x4 (&acc)[2][2][4][2], const Unit& u, int wr, int wc, int fr, int fq) const {
        const int pnl = u.pn - u.e * 8; const int row0 = u.pm * BM + wr * 64 + fr, cg = pnl * 128 + wc * 32 + 8 * fq;
        const float* bp = b1 + (size_t)u.e * 2048 + cg;
        const f32x4 bg0 = *(const f32x4*)(bp), bg1 = *(const f32x4*)(bp + 4), bl0 = *(const f32x4*)(bp + 1024), bl1 = *(const f32x4*)(bp + 1028);
#pragma unroll
        for (int ai = 0; ai < 2; ++ai)
#pragma unroll
            for (int m = 0; m < 4; ++m) { unsigned char* rowp = O + (size_t)(row0 + ai * HALF + m * 16) * FF + cg;
                f32x4 o[2];
#pragma unroll
                for (int n = 0; n < 2; ++n) { const f32x4 gl = acc[ai][0][m][n] + (n ? bg1 : bg0), li = acc[ai][1][m][n] + (n ? bl1 : bl0);
#pragma unroll
                    for (int j = 0; j < 4; ++j) { const float gq = fminf(gl[j], 7.0f), lq = __builtin_amdgcn_fmed3f(li[j], -7.0f, 7.0f);
                        o[n][j] = gq * __builtin_amdgcn_rcpf(1.0f + __builtin_amdgcn_exp2f(-2.4554669f * gq)) * (lq + 1.0f); } }
                u32x2 w; w.x = pk_fp8x4(o[0][0], o[0][1], o[0][2], o[0][3]); w.y = pk_fp8x4(o[1][0], o[1][1], o[1][2], o[1][3]);
                *(u32x2*)rowp = w; }
    }
};
struct EpiY {
    static constexpr int PERM = 2; static constexpr int NS = 8;
    unsigned char* O; const float* b2;
    __device__ __forceinline__ NOPK void operator()(const f32x4 (&acc)[2][2][4][2], const Unit& u, int wr, int wc, int fr, int fq) const {
        const int pnl = u.pn - u.e * 4; const int row0 = u.pm * BM + wr * 64 + fr, col0 = pnl * BM + wc * 64 + 16 * fq;
        f32x4 bv[2][2];
#pragma unroll
        for (int bj = 0; bj < 2; ++bj)
#pragma unroll
            for (int n = 0; n < 2; ++n) bv[bj][n] = *(const f32x4*)(b2 + (size_t)u.e * D + col0 + 8 * bj + 4 * n) * Y8_SCALE;
#define Y8C(x) __builtin_amdgcn_fmed3f((x), -448.f, 448.f)
#pragma unroll
        for (int ai = 0; ai < 2; ++ai)
#pragma unroll
            for (int m = 0; m < 4; ++m) { unsigned char* rowp = O + (size_t)(row0 + ai * HALF + m * 16) * D + col0;
                u32x4 w;
#pragma unroll
                for (int bj = 0; bj < 2; ++bj) { const f32x4 v0 = acc[ai][bj][m][0] + bv[bj][0], v1 = acc[ai][bj][m][1] + bv[bj][1];
                    w[2 * bj] = pk_fp8x4(Y8C(v0[0]), Y8C(v0[1]), Y8C(v0[2]), Y8C(v0[3])); w[2 * bj + 1] = pk_fp8x4(Y8C(v1[0]), Y8C(v1[1]), Y8C(v1[2]), Y8C(v1[3])); }
                *(u32x4*)rowp = w; }
#undef Y8C
    }
};
}

struct Frame {
    LAS unsigned char* lds;
    int tid, lane, wave, G, bid;
    float* out; unsigned char* ws;
};
struct Args { const float* in[N_IN]; float* out; unsigned char* ws; int ph_lo, ph_hi; };

__device__ __forceinline__ NOPK void build_tab(Frame& F, int l) {
    LAS int* tab = (LAS int*)(F.lds + TAB_OFF);
    const unsigned* cnt = (const unsigned*)(F.ws + WS_CTL) + CW_CNT + 64 * l;
    if (F.tid < 32) tab[64 + F.tid] = (int)__hip_atomic_load(cnt + F.tid, __ATOMIC_RELAXED, __HIP_MEMORY_SCOPE_AGENT);
    __syncthreads();
    if (F.tid == 0) { int s = 0; for (int e = 0; e < 32; ++e) { tab[e] = s; s += (tab[64 + e] + 255) >> 8; } tab[32] = s; }
    __syncthreads();
    { LAS unsigned char* texp = (LAS unsigned char*)(F.lds + TAB_OFF + 1024); const int T = tab[32];
      for (int i = F.tid; i < T; i += 512) { int lo = 0, hi = 31; while (lo < hi) { const int mid = (lo + hi + 1) >> 1; if (tab[mid] <= i) lo = mid; else hi = mid - 1; } texp[i] = (unsigned char)lo; } }
    __syncthreads();
}

__device__ __forceinline__ NOPK void transpose_item(const float* W, int ldn, int k0, int n0, bf16* WT, int Kd, int drow0, int kvalid, LAS float* scr, int lane) {
#pragma unroll
    for (int i = 0; i < 8; ++i) { const int kk = 8 * i + (lane >> 3), nq = 4 * (lane & 7);
        const f32x4 v = kk < kvalid ? *(const f32x4*)(W + (size_t)(k0 + kk) * ldn + n0 + nq) : (f32x4){0.f, 0.f, 0.f, 0.f};
        scr[kk * 33 + nq] = v.x; scr[kk * 33 + nq + 1] = v.y; scr[kk * 33 + nq + 2] = v.z; scr[kk * 33 + nq + 3] = v.w; }
    LDS_WAIT(); asm volatile("" ::: "memory");
    const int c = lane & 7;
    if (8 * c < kvalid) {
#pragma unroll
        for (int j = 0; j < 4; ++j) { const int n = (lane >> 3) + 8 * j; const LAS float* s = scr + (8 * c) * 33 + n;
            u32x4 o; o.x = cvt_pk_bf16(s[0 * 33], s[1 * 33]); o.y = cvt_pk_bf16(s[2 * 33], s[3 * 33]); o.z = cvt_pk_bf16(s[4 * 33], s[5 * 33]); o.w = cvt_pk_bf16(s[6 * 33], s[7 * 33]);
            *(u32x4*)(WT + (size_t)(drow0 + n) * Kd + k0 + 8 * c) = o; }
    }
    LDS_WAIT(); asm volatile("" ::: "memory");
}
__device__ __forceinline__ NOPK void transpose_item_fp8(const float* W, int ldn, int k0, int n0, unsigned char* WT, int Kd, int drow0, LAS float* scr, int lane) {
#pragma unroll
    for (int i = 0; i < 8; ++i) { const int kk = 8 * i + (lane >> 3), nq = 4 * (lane & 7);
        const f32x4 v = *(const f32x4*)(W + (size_t)(k0 + kk) * ldn + n0 + nq);
        scr[kk * 33 + nq] = v.x; scr[kk * 33 + nq + 1] = v.y; scr[kk * 33 + nq + 2] = v.z; scr[kk * 33 + nq + 3] = v.w; }
    LDS_WAIT(); asm volatile("" ::: "memory");
    const int pc = lane & 3;
#define Q8(i) fminf(fmaxf(sp[(i) * 33] * W8_SCALE, -448.f), 448.f)
#pragma unroll
    for (int s2 = 0; s2 < 2; ++s2) { const int n = 16 * s2 + (lane >> 2); const LAS float* sp = scr + (16 * pc) * 33 + n;
        u32x4 o; o.x = pk_fp8x4(Q8(0), Q8(1), Q8(2), Q8(3)); o.y = pk_fp8x4(Q8(4), Q8(5), Q8(6), Q8(7)); o.z = pk_fp8x4(Q8(8), Q8(9), Q8(10), Q8(11)); o.w = pk_fp8x4(Q8(12), Q8(13), Q8(14), Q8(15));
        *(u32x4*)(WT + (size_t)(drow0 + n) * Kd + k0 + 16 * pc) = o; }
#undef Q8
    LDS_WAIT(); asm volatile("" ::: "memory");
}
__device__ __forceinline__ NOPK void p0_prologue(Frame& F, const Args& A) {
    if (F.bid < 192) {
        LAS float* cond = (LAS float*)F.lds;
        for (int i = F.tid; i < 32 * 1024; i += 512) { const float v = A.in[I_C][i]; cond[i] = v / (1.0f + __expf(-v)); }
        __syncthreads();
        const int l = F.bid / 96, j0 = (F.bid % 96) * 64;
        const float* W = A.in[I_ADAW] + (size_t)l * D * 6144 + j0;
        const int cq = F.lane & 15, kr = F.lane >> 4, b0 = F.wave * 4;
        f32x4 acc[4];
#pragma unroll
        for (int i = 0; i < 4; ++i) acc[i] = (f32x4){0.f, 0.f, 0.f, 0.f};
#pragma unroll 8
        for (int kk = 0; kk < 256; ++kk) { const int k = 4 * kk + kr; const f32x4 w = *(const f32x4*)(W + (size_t)k * 6144 + 4 * cq);
#pragma unroll
            for (int i = 0; i < 4; ++i) acc[i] += w * cond[(b0 + i) * 1024 + k]; }
#pragma unroll
        for (int i = 0; i < 4; ++i)
#pragma unroll
            for (int j = 0; j < 4; ++j) { float v = acc[i][j]; v += __shfl_xor(v, 16); v += __shfl_xor(v, 32); acc[i][j] = v; }
        if (kr == 0) { const f32x4 bb = *(const f32x4*)(A.in[I_ADAB] + (size_t)l * 6144 + j0 + 4 * cq);
#pragma unroll
            for (int i = 0; i < 4; ++i) *(f32x4*)((float*)(F.ws + WS_MOD) + ((size_t)l * 32 + b0 + i) * 6144 + j0 + 4 * cq) = acc[i] + bb; }
        __syncthreads();
    }
    if (F.bid == F.G - 1) {
        for (int i = F.tid; i < 2 * D * NE; i += 512) { const int l = i >> 15, r = i & 32767, k = r >> 5, e = r & 31; const float w = A.in[I_RW][i];
            const unsigned hi = cvt_pk_bf16(w, 0.f) & 0xffffu; const float rem = w - __uint_as_float(hi << 16); const unsigned lo = cvt_pk_bf16(rem, 0.f) & 0xffffu;
            bf16* dst = (bf16*)(F.ws + WS_LORA + (size_t)l * LORA_STRIDE + LO_RWS); dst[e * D + k] = (bf16)hi; dst[NE * D + e * D + k] = (bf16)lo; }
    }
    LAS float* scr = (LAS float*)(F.lds + F.wave * 16384);
    const int gw = F.bid * 8 + F.wave, NGW = F.G * 8;
    constexpr int I_IN = 16 * 104, I_OUT = 16 * 32, I_E1 = 16 * 64, I_E2 = 16 * 32;
    constexpr int N_IN_ITEMS = 2 * I_IN, N_OUT_ITEMS = 2 * I_OUT, N_E1 = 64 * I_E1, N_E2 = 64 * I_E2, N_LORA = 2 * (16 + 16 + 32) + 8 + 16;
    constexpr int NITEMS = N_IN_ITEMS + N_OUT_ITEMS + N_E1 + N_E2 + N_LORA;
    for (int it = gw; it < NITEMS; it += NGW) {
        int r = it;
        if (r < N_E1) { const int m = r / I_E1, q = r % I_E1, kb = q / 64, nb = q % 64, n0 = 32 * nb, jj = n0 & 1023, hi = n0 >> 10;
            transpose_item_fp8(A.in[I_W1] + (size_t)m * D * 2048, 2048, 64 * kb, n0, F.ws + WS_W1 + (size_t)m * 2048 * D, D, (jj >> 7) * 256 + hi * 128 + (jj & 127), scr, F.lane); continue; } r -= N_E1;
        if (r < N_E2) { const int m = r / I_E2, q = r % I_E2, kb = q / 32, nb = q % 32;
            transpose_item_fp8(A.in[I_W2] + (size_t)m * FF * D, D, 64 * kb, 32 * nb, F.ws + WS_W2 + (size_t)m * D * FF, FF, 32 * nb, scr, F.lane); continue; } r -= N_E2;
        if (r < N_IN_ITEMS) { const int l = r / I_IN, q = r % I_IN, kb = q / 104, nb = q % 104;
            transpose_item(A.in[I_WIN] + (size_t)l * D * C_IN, C_IN, 64 * kb, 32 * nb, (bf16*)(F.ws + WS_WIN) + (size_t)l * C_IN * D, D, 32 * nb, 64, scr, F.lane); continue; } r -= N_IN_ITEMS;
        if (r < N_OUT_ITEMS) { const int l = r / I_OUT, q = r % I_OUT, kb = q / 32, nb = q % 32;
            transpose_item(A.in[I_WOUT] + (size_t)l * D * D, D, 64 * kb, 32 * nb, (bf16*)(F.ws + WS_WOUT) + (size_t)l * D * D, D, 32 * nb, 64, scr, F.lane); continue; } r -= N_OUT_ITEMS;
        if (r < 128) { const int l = r / 64, q = r % 64; unsigned char* lo = F.ws + WS_LORA + (size_t)l * LORA_STRIDE;
            if (q < 16) transpose_item(A.in[I_DUP] + (size_t)l * 64 * DR, DR, 0, 32 * q, (bf16*)(lo + LO_DUP), 64, 32 * q, 64, scr, F.lane);
            else if (q < 32) transpose_item(A.in[I_IUP] + (size_t)l * 64 * DR, DR, 0, 32 * (q - 16), (bf16*)(lo + LO_IUP), 64, 32 * (q - 16), 64, scr, F.lane);
            else { const int qq = q - 32, kb = qq / 16, nb = qq % 16; transpose_item(A.in[I_GUP] + (size_t)l * 128 * DR, DR, 64 * kb, 32 * nb, (bf16*)(lo + LO_GUP), 128, 32 * nb, 64, scr, F.lane); }
            continue; } r -= 128;
        { unsigned char* lo = F.ws + WS_LORA + (size_t)1 * LORA_STRIDE;
          if (r < 8) transpose_item(A.in[I_VRD], 32, 64 * r, 0, (bf16*)(lo + LO_VRD), DR, 0, 64, scr, F.lane);
          else transpose_item(A.in[I_VRU], DR, 0, 32 * (r - 8), (bf16*)(lo + LO_VRU), 32, 32 * (r - 8), 32, scr, F.lane); }
    }
}

template <int MODE> __device__ __forceinline__ NOPK void norm_phase(Frame& F, const Args& A, int l) {
    if (MODE != 0) build_tab(F, MODE == 1 ? 0 : 1);
    const LAS int* tab = (const LAS int*)(F.lds + TAB_OFF);
    const float* mod = (const float*)(F.ws + WS_MOD);
    const unsigned char* Y = F.ws + WS_Y;
    const unsigned* tokslot = (const unsigned*)(F.ws + WS_TOKSLOT); const float* tokgate = (const float*)(F.ws + WS_TOKGATE);
    bf16* H = (bf16*)(F.ws + WS_H);
    const int gw = F.bid * 8 + F.wave, NGW = F.G * 8, TPW = M / NGW;
    for (int t0 = gw * TPW; t0 < M; t0 += NGW * TPW) {
        const int b = t0 / SEQ;
        f32x4 g1[4], sc[4], sh[4], g2[4];
#pragma unroll
        for (int j = 0; j < 4; ++j) { const int col = 4 * (64 * j + F.lane);
            if (MODE != 2) { g1[j] = *(const f32x4*)(A.in[I_N1G] + (size_t)l * D + col); sh[j] = *(const f32x4*)(mod + ((size_t)l * 32 + b) * 6144 + col); sc[j] = *(const f32x4*)(mod + ((size_t)l * 32 + b) * 6144 + 1024 + col) + 1.0f; }
            if (MODE != 0) g2[j] = *(const f32x4*)(mod + ((size_t)(MODE == 1 ? 0 : 1) * 32 + b) * 6144 + 5120 + col); }
        for (int tok = t0; tok < t0 + TPW; ++tok) {
            f32x4 v[4];
#pragma unroll
            for (int j = 0; j < 4; ++j) {
                if (MODE == 0) v[j] = *(const f32x4*)(A.in[I_X] + (size_t)tok * D + 4 * (64 * j + F.lane));
                else { const u32x2 w = *(const u32x2*)((const bf16*)(F.ws + WS_X1) + (size_t)tok * D + 4 * (64 * j + F.lane)); v[j] = (f32x4){bflo(w.x), bfhi(w.x), bflo(w.y), bfhi(w.y)}; } }
            if (MODE != 0) {
                f32x4 a[4];
#pragma unroll
                for (int j = 0; j < 4; ++j) a[j] = (f32x4){0.f, 0.f, 0.f, 0.f};
#pragma unroll
                for (int k = 0; k < 4; ++k) { const unsigned ts = tokslot[tok * 4 + k]; const float gk = tokgate[tok * 4 + k] * (1.0f / Y8_SCALE);
                    const size_t row = (size_t)tab[ts >> 16] * 256 + (ts & 0xffffu); const unsigned char* yr = Y + row * D;
#pragma unroll
                    for (int j = 0; j < 4; ++j) { const int w = *(const int*)(yr + 4 * (64 * j + F.lane)); const f32x2 lo = __builtin_amdgcn_cvt_pk_f32_fp8(w, false), hi = __builtin_amdgcn_cvt_pk_f32_fp8(w, true);
                        a[j] += gk * (f32x4){lo.x, lo.y, hi.x, hi.y}; } }
#pragma unroll
                for (int j = 0; j < 4; ++j) { v[j] += g2[j] * a[j]; *(f32x4*)(F.out + (size_t)tok * D + 4 * (64 * j + F.lane)) = v[j]; }
            }
            if (MODE != 2) {
                float ss = 0.f;
#pragma unroll
                for (int j = 0; j < 4; ++j) ss += (v[j].x * v[j].x + v[j].y * v[j].y) + (v[j].z * v[j].z + v[j].w * v[j].w);
                const float rstd = 1.0f / sqrtf(wave_sum(ss) * (1.0f / D) + NORM_EPS);
#pragma unroll
                for (int j = 0; j < 4; ++j) { const f32x4 h = v[j] * rstd * g1[j] * sc[j] + sh[j]; u32x2 w; w.x = cvt_pk_bf16(h.x, h.y); w.y = cvt_pk_bf16(h.z, h.w);
                    *(u32x2*)(H + (size_t)tok * D + 4 * (64 * j + F.lane)) = w; }
            }
        }
    }
}

__device__ __forceinline__ NOPK u32x4 ldg16(const bf16* p) { return *(const u32x4*)p; }
__device__ __forceinline__ NOPK void unpack8(const u32x4 w, float (&f)[8]) { f[0] = bflo(w.x); f[1] = bfhi(w.x); f[2] = bflo(w.y); f[3] = bfhi(w.y); f[4] = bflo(w.z); f[5] = bfhi(w.z); f[6] = bflo(w.w); f[7] = bfhi(w.w); }
__device__ __forceinline__ NOPK void shifted8(const bf16* Z, size_t tokrow, bool has_prev, int col, const float* mu, float (&o)[8]) {
    float c[8], p[8]; unpack8(ldg16(Z + tokrow * C_IN + col), c);
    if (has_prev) unpack8(ldg16(Z + (tokrow - 1) * C_IN + col), p); else {
#pragma unroll
        for (int i = 0; i < 8; ++i) p[i] = 0.f; }
    const f32x4 m0 = *(const f32x4*)(mu + col), m1 = *(const f32x4*)(mu + col + 4);
#pragma unroll
    for (int i = 0; i < 8; ++i) o[i] = c[i] + (p[i] - c[i]) * (i < 4 ? m0[i] : m1[i - 4]);
}
__device__ __forceinline__ NOPK void ld8f(const float* p, float (&o)[8]) { const f32x4 a = *(const f32x4*)p, b = *(const f32x4*)(p + 4); o[0] = a.x; o[1] = a.y; o[2] = a.z; o[3] = a.w; o[4] = b.x; o[5] = b.y; o[6] = b.z; o[7] = b.w; }
__device__ __forceinline__ NOPK void lds8f(const LAS float* p, float (&o)[8]) { const f32x4 a = *(const LAS f32x4*)p, b = *(const LAS f32x4*)(p + 4); o[0] = a.x; o[1] = a.y; o[2] = a.z; o[3] = a.w; o[4] = b.x; o[5] = b.y; o[6] = b.z; o[7] = b.w; }
__device__ __forceinline__ NOPK bf16x8 pack8(const float (&f)[8]) { u32x4 w; w.x = cvt_pk_bf16(f[0], f[1]); w.y = cvt_pk_bf16(f[2], f[3]); w.z = cvt_pk_bf16(f[4], f[5]); w.w = cvt_pk_bf16(f[6], f[7]); return __builtin_bit_cast(bf16x8, w); }

__device__ __forceinline__ NOPK void n2r_phase(Frame& F, const Args& A, int l) {
    constexpr int XP = 1032, XBUF = 33 * 1024;
    LAS float* SS = (LAS float*)(F.lds + 2 * XBUF);
    LAS float* PL = SS + 128;
    LAS float* LG = PL + 8 * 512;
    LAS unsigned* ent = (LAS unsigned*)(LG + 512 + 128);
    LAS unsigned* lcnt = ent + 2048; LAS unsigned* lbase = lcnt + 32;
    LAS float* GG = (LAS float*)(lbase + 32); LAS float* SH = GG + 1024;
    static_assert(2 * XBUF + (128 + 4096 + 640) * 4 + 8192 + 256 + 8192 <= MISC_OFF, "n2r LDS map");
    if (F.tid < 32) lcnt[F.tid] = 0u;
    const float* mod = (const float*)(F.ws + WS_MOD);
    const bf16* X1 = (const bf16*)(F.ws + WS_X1);
    unsigned char* H8 = F.ws + WS_H;
    unsigned* gcnt = (unsigned*)(F.ws + WS_CTL) + CW_CNT + 64 * l;
    int* rowtok = (int*)(F.ws + WS_ROWTOK); unsigned* tokslot = (unsigned*)(F.ws + WS_TOKSLOT); float* tokgate = (float*)(F.ws + WS_TOKGATE);
    const int fr = F.lane & 15, kq = F.lane >> 4, w = F.wave;
    bf16x8 WB[4][2][2];
    { const bf16* src = (const bf16*)(F.ws + WS_LORA + (size_t)l * LORA_STRIDE + LO_RWS);
#pragma unroll
      for (int ks = 0; ks < 4; ++ks)
#pragma unroll
          for (int nb = 0; nb < 2; ++nb)
#pragma unroll
              for (int hl = 0; hl < 2; ++hl) WB[ks][nb][hl] = *(const bf16x8*)(src + (size_t)hl * NE * D + (size_t)(16 * nb + fr) * D + 128 * w + 32 * ks + 8 * kq); }
    const float rb = A.in[I_RB][l * NE + (F.lane & 31)];
#define N2_DMA(TILE, BUF) do { _Pragma("unroll") for (int k_ = 0; k_ < 5; ++k_) { const int i_ = w + 8 * k_; if (i_ < 33) { const int P_ = i_ * 64 + F.lane; int row_ = P_ / 129; const int pc_ = P_ - row_ * 129; \
            const bool ok_ = row_ < 16 && pc_ < 128; row_ = row_ < 16 ? row_ : 15; \
            __builtin_amdgcn_global_load_lds((const unsigned*)(X1 + (size_t)(blk * 256 + (TILE) * 16 + row_) * D + (ok_ ? pc_ * 8 : 0)), (LAS unsigned*)(F.lds + (BUF) * XBUF + i_ * 1024), 16, 0, 0); } } } while (0)
    for (int blk = F.bid; blk < M / 256; blk += F.G) {
        const int b = (blk * 256) / SEQ;
        const float* g2p = A.in[I_N2G] + (size_t)l * D; const float* shp = mod + ((size_t)l * 32 + b) * 6144 + 3072; const float* scp = shp + 1024;
        N2_DMA(0, 0);
        for (int i = F.tid; i < D; i += 512) { GG[i] = g2p[i] * (1.0f + scp[i]); SH[i] = shp[i]; }
#pragma unroll 1
        for (int tile = 0; tile < 16; ++tile) {
            if (tile + 1 < 16) { N2_DMA(tile + 1, (tile + 1) & 1); if (w == 0) asm volatile("s_waitcnt vmcnt(5)" ::: "memory"); else asm volatile("s_waitcnt vmcnt(4)" ::: "memory"); }
            else asm volatile("s_waitcnt vmcnt(0)" ::: "memory");
            LDS_BARRIER();
            const LAS bf16* xt = (const LAS bf16*)(F.lds + (tile & 1) * XBUF) + fr * XP + 128 * w + 8 * kq;
            float x[4][8]; float ss = 0.f;
#pragma unroll
            for (int ks = 0; ks < 4; ++ks) { unpack8(*(const LAS u32x4*)(xt + 32 * ks), x[ks]);
#pragma unroll
                for (int i = 0; i < 8; ++i) ss += x[ks][i] * x[ks][i]; }
            ss += __shfl_xor(ss, 16); ss += __shfl_xor(ss, 32);
            if (kq == 0) SS[w * 16 + fr] = ss;
            LDS_BARRIER();
            float tot = 0.f;
#pragma unroll
            for (int ww = 0; ww < 8; ++ww) tot += SS[ww * 16 + fr];
            const float rstd = 1.0f / sqrtf(tot * (1.0f / D) + NORM_EPS);
            const int tok = blk * 256 + tile * 16 + fr;
            f32x4 acc0 = (f32x4){0.f, 0.f, 0.f, 0.f}, acc1 = acc0;
#pragma unroll
            for (int ks = 0; ks < 4; ++ks) { const int col = 128 * w + 32 * ks + 8 * kq;
                float g[8], sh[8], lo[8]; lds8f(GG + col, g); lds8f(SH + col, sh);
#pragma unroll
                for (int i = 0; i < 8; ++i) x[ks][i] = x[ks][i] * rstd * g[i] + sh[i];
                const bf16x8 hi8 = pack8(x[ks]); const u32x4 hw = __builtin_bit_cast(u32x4, hi8);
                { u32x2 q8; q8.x = pk_fp8x4(__builtin_amdgcn_fmed3f(x[ks][0], -448.f, 448.f), __builtin_amdgcn_fmed3f(x[ks][1], -448.f, 448.f), __builtin_amdgcn_fmed3f(x[ks][2], -448.f, 448.f), __builtin_amdgcn_fmed3f(x[ks][3], -448.f, 448.f));
                  q8.y = pk_fp8x4(__builtin_amdgcn_fmed3f(x[ks][4], -448.f, 448.f), __builtin_amdgcn_fmed3f(x[ks][5], -448.f, 448.f), __builtin_amdgcn_fmed3f(x[ks][6], -448.f, 448.f), __builtin_amdgcn_fmed3f(x[ks][7], -448.f, 448.f));
                  *(u32x2*)(H8 + (size_t)tok * D + col) = q8; }
                lo[0] = x[ks][0] - bflo(hw.x); lo[1] = x[ks][1] - bfhi(hw.x); lo[2] = x[ks][2] - bflo(hw.y); lo[3] = x[ks][3] - bfhi(hw.y); lo[4] = x[ks][4] - bflo(hw.z); lo[5] = x[ks][5] - bfhi(hw.z); lo[6] = x[ks][6] - bflo(hw.w); lo[7] = x[ks][7] - bfhi(hw.w);
                const bf16x8 lo8 = pack8(lo);
                acc0 = __builtin_amdgcn_mfma_f32_16x16x32_bf16(hi8, WB[ks][0][0], acc0, 0, 0, 0); acc1 = __builtin_amdgcn_mfma_f32_16x16x32_bf16(hi8, WB[ks][1][0], acc1, 0, 0, 0);
                acc0 = __builtin_amdgcn_mfma_f32_16x16x32_bf16(lo8, WB[ks][0][0], acc0, 0, 0, 0); acc1 = __builtin_amdgcn_mfma_f32_16x16x32_bf16(lo8, WB[ks][1][0], acc1, 0, 0, 0);
                acc0 = __builtin_amdgcn_mfma_f32_16x16x32_bf16(hi8, WB[ks][0][1], acc0, 0, 0, 0); acc1 = __builtin_amdgcn_mfma_f32_16x16x32_bf16(hi8, WB[ks][1][1], acc1, 0, 0, 0); }
#pragma unroll
            for (int j = 0; j < 4; ++j) { PL[w * 512 + (4 * kq + j) * 32 + fr] = acc0[j]; PL[w * 512 + (4 * kq + j) * 32 + 16 + fr] = acc1[j]; }
            LDS_BARRIER();
            {
                const int tt = 2 * w + (F.lane >> 5), e = F.lane & 31;
                float logit = rb;
#pragma unroll
                for (int ww = 0; ww < 8; ++ww) logit += PL[ww * 512 + tt * 32 + e];
                LG[tt * 32 + e] = logit;
                LDS_WAIT(); asm volatile("" ::: "memory");
                int rank = 0;
#pragma unroll
                for (int q = 0; q < 8; ++q) { const f32x4 o = *(const LAS f32x4*)(LG + tt * 32 + 4 * q);
#pragma unroll
                    for (int j = 0; j < 4; ++j) { const int e2 = 4 * q + j; rank += (o[j] > logit || (o[j] == logit && e2 < e)) ? 1 : 0; } }
                if (rank < 4) { LG[512 + tt * 8 + rank] = __int_as_float(e); LG[512 + tt * 8 + 4 + rank] = logit; }
                LDS_WAIT(); asm volatile("" ::: "memory");
                if (e < 4) {
                    const f32x4 sv = *(const LAS f32x4*)(LG + 512 + tt * 8 + 4);
                    const float inv = 1.0f / (((1.0f + __expf(sv.y - sv.x)) + __expf(sv.z - sv.x)) + __expf(sv.w - sv.x));
                    const int ek = __float_as_int(LG[512 + tt * 8 + e]); const float gk = __expf(LG[512 + tt * 8 + 4 + e] - sv.x) * inv;
                    const unsigned rk = __hip_atomic_fetch_add(lcnt + ek, 1u, __ATOMIC_RELAXED, __HIP_MEMORY_SCOPE_WORKGROUP);
                    ent[((tile * 16 + tt) * 4 + e) * 2] = ((unsigned)ek << 16) | rk; ent[((tile * 16 + tt) * 4 + e) * 2 + 1] = __float_as_uint(gk); }
            }
        }
        __syncthreads();
        if (F.tid < 32) lbase[F.tid] = atomicAdd(gcnt + F.tid, lcnt[F.tid]);
        __syncthreads();
        for (int idx = F.tid; idx < 1024; idx += 512) { const unsigned wv = ent[idx * 2]; const int ek = wv >> 16; const unsigned slot = lbase[ek] + (wv & 0xffffu); const int tok = blk * 256 + (idx >> 2);
            rowtok[ek * ECAP + slot] = tok; tokslot[tok * 4 + (idx & 3)] = ((unsigned)ek << 16) | slot; tokgate[tok * 4 + (idx & 3)] = __uint_as_float(ent[idx * 2 + 1]); }
        __syncthreads();
        if (F.tid < 32) lcnt[F.tid] = 0u;
        __syncthreads();
    }
#undef N2_DMA
}

__device__ __forceinline__ NOPK void prep_phase(Frame& F, const Args& A, int l) {
    const bf16* Z = (const bf16*)(F.ws + WS_Z);
    const unsigned char* lo = F.ws + WS_LORA + (size_t)l * LORA_STRIDE;
    const bf16* dupT = (const bf16*)(lo + LO_DUP); const bf16* iupT = (const bf16*)(lo + LO_IUP); const bf16* gupT = (const bf16*)(lo + LO_GUP);
    const bf16* vrdT = (const bf16*)(lo + LO_VRD); const bf16* vruT = (const bf16*)(lo + LO_VRU);
    bf16* OPS = (bf16*)(F.ws + WS_OPS); bf16* QN = (bf16*)(F.ws + WS_QN); bf16* KN = (bf16*)(F.ws + WS_KN); bf16* VF = (bf16*)(F.ws + WS_VF); bf16* VFIRST = (bf16*)(F.ws + WS_VFIRST); float* BON = (float*)(F.ws + WS_BON);
    constexpr int ZROW = 1544, ZBUF = 53248, AFROW = 264, AF_OFF = 2 * ZBUF, SW_OFF = AF_OFF + 16 * AFROW * 2, MA_OFF = SW_OFF + 8 * 2048, PT_OFF = MA_OFF + 4096;
    constexpr int PT_MU = 0, PT_DW0 = 1792, PT_IA0 = 2304, PT_KK = 2816, PT_KA = 3328, PT_VRB = 3840, PT_QG = 4352, PT_KG = 4416, PT_RK = 4480, PT_N = 4992;
    static_assert(PT_OFF + PT_N * 4 <= MISC_OFF, "prep LDS map");
    LAS bf16* AF = (LAS bf16*)(F.lds + AF_OFF);
    LAS bf16* sW = (LAS bf16*)(F.lds + SW_OFF + F.wave * 2048);
    LAS float* PT = (LAS float*)(F.lds + PT_OFF);
    const int h = F.wave, lane0 = F.lane;
    for (int i = F.tid; i < PT_N; i += 512) {
        float v;
        if (i < PT_DW0) v = A.in[I_MU][(size_t)l * C_RWKV + i];
        else if (i < PT_IA0) v = A.in[I_DW0][l * DR + i - PT_DW0];
        else if (i < PT_KK) v = A.in[I_IA0][l * DR + i - PT_IA0];
        else if (i < PT_KA) v = A.in[I_KK][l * DR + i - PT_KK];
        else if (i < PT_VRB) v = A.in[I_KA][l * DR + i - PT_KA];
        else if (i < PT_QG) v = A.in[I_VRB][i - PT_VRB];
        else if (i < PT_KG) v = A.in[I_QG][l * HD + i - PT_QG];
        else if (i < PT_RK) v = A.in[I_KG][l * HD + i - PT_KG];
        else v = A.in[I_RK][l * DR + i - PT_RK];
        PT[i] = v;
    }
    { LAS float* m = (LAS float*)(F.lds + MA_OFF); m[F.tid] = 0.f; m[512 + F.tid] = 0.f; }
#define PREP_DMA(uu, buf) do { const int tk0_ = (uu) * 16; _Pragma("unroll") for (int k_ = 0; k_ < 7; ++k_) { const int i_ = F.wave + 8 * k_; if (i_ < 52) { int ln_ = lane; asm volatile("" : "+v"(ln_)); const int P_ = i_ * 64 + ln_; int row_ = P_ / 193; const int pc_ = P_ - row_ * 193; \
        const bool ok_ = row_ < 17; row_ = ok_ ? row_ : 16; const int spc_ = (ok_ && pc_ < 192) ? pc_ : 0; int tg_ = tk0_ - 1 + row_; tg_ = tg_ < 0 ? 0 : tg_; \
        __builtin_amdgcn_global_load_lds((const unsigned*)(Z + (size_t)tg_ * C_IN + spc_ * 8), (LAS unsigned*)(F.lds + (buf) * ZBUF + i_ * 1024), 16, 0, 0); } } } while (0)
#define PREP_LDR(uu) do { const size_t tk_ = (size_t)(uu) * 16 + tau; aq0 = ldg16(Z + tk_ * C_IN + 1792 + hc); aq1 = ldg16(Z + tk_ * C_IN + 1792 + hc + 32); ak0 = ldg16(Z + tk_ * C_IN + 2304 + hc); ak1 = ldg16(Z + tk_ * C_IN + 2304 + hc + 32); \
        av0 = ldg16(Z + tk_ * C_IN + 2816 + hc); av1 = ldg16(Z + tk_ * C_IN + 2816 + hc + 32); \
        const size_t tf_ = (size_t)(uu) * 16 + fr; lcC = ldg16(Z + tf_ * C_IN + 1536 + 32 * h + 8 * kq); lcP = ldg16(Z + (tf_ > 0 ? tf_ - 1 : 0) * C_IN + 1536 + 32 * h + 8 * kq); } while (0)
#define ZSH8(rr, hasp, col, OUT) do { float c_[8], p_[8], m_[8]; unpack8(*(const LAS u32x4*)(ZS + ((rr) + 1) * ZROW + (col)), c_); unpack8(*(const LAS u32x4*)(ZS + (rr) * ZROW + (col)), p_); lds8f(PT + PT_MU + (col), m_); \
            _Pragma("unroll") for (int i_ = 0; i_ < 8; ++i_) { const float pp_ = (hasp) ? p_[i_] : 0.f; OUT[i_] = c_[i_] + (pp_ - c_[i_]) * m_[i_]; } } while (0)
#define ZSH16(rr, hasp, col, OUT) do { ZSH8(rr, hasp, col, (*(float(*)[8])&OUT[0])); ZSH8(rr, hasp, (col) + 32, (*(float(*)[8])&OUT[8])); } while (0)
#define PREP_LDB(BF, WT, KD, NKS) do { int fo_ = (64 * h + fr) * (KD) + 8 * kq; asm volatile("" : "+v"(fo_));     \
        _Pragma("unroll") for (int nb_ = 0; nb_ < 4; ++nb_) _Pragma("unroll") for (int ks_ = 0; ks_ < (NKS); ++ks_) BF[nb_][ks_] = *(const bf16x8*)((WT) + fo_ + 16 * nb_ * (KD) + 32 * ks_); } while (0)
#define PREP_LORA(BF, ACOL, NKS) do { bf16x8 Af_[NKS]; _Pragma("unroll") for (int ks_ = 0; ks_ < (NKS); ++ks_) Af_[ks_] = *(const LAS bf16x8*)(AF + fr * AFROW + (ACOL) + 32 * ks_ + 8 * kq); \
        _Pragma("unroll") for (int nb_ = 0; nb_ < 4; ++nb_) { f32x4 acc_ = (f32x4){0.f, 0.f, 0.f, 0.f}; \
            _Pragma("unroll") for (int ks_ = 0; ks_ < (NKS); ++ks_) acc_ = __builtin_amdgcn_mfma_f32_16x16x32_bf16(Af_[ks_], BF[nb_][ks_], acc_, 0, 0, 0); \
            _Pragma("unroll") for (int j_ = 0; j_ < 4; ++j_) sW[(4 * kq + j_) * 64 + 16 * nb_ + fr] = (bf16)(cvt_pk_bf16(acc_[j_], 0.f) & 0xffffu); } \
        LDS_WAIT(); asm volatile("" ::: "memory"); } while (0)
#define SW16(OUT) do { unpack8(*(const LAS u32x4*)(sW + tau * 64 + 8 * q), (*(float(*)[8])&OUT[0])); unpack8(*(const LAS u32x4*)(sW + tau * 64 + 8 * q + 32), (*(float(*)[8])&OUT[8])); } while (0)
#define PT16(OFF, OUT) do { lds8f(PT + (OFF), (*(float(*)[8])&OUT[0])); lds8f(PT + (OFF) + 32, (*(float(*)[8])&OUT[8])); } while (0)
#define ST16(DST, V) do { *(u32x4*)(DST) = __builtin_bit_cast(u32x4, pack8(*(const float(*)[8])&V[0])); *(u32x4*)((DST) + 32) = __builtin_bit_cast(u32x4, pack8(*(const float(*)[8])&V[8])); } while (0)
#define ST16O(DST, V) do { *(u32x4*)(DST) = __builtin_bit_cast(u32x4, pack8(*(const float(*)[8])&V[0])); *(u32x4*)((DST) + 512) = __builtin_bit_cast(u32x4, pack8(*(const float(*)[8])&V[8])); } while (0)
    constexpr int NU = M / 16;
    u32x4 aq0, aq1, ak0, ak1, av0, av1, lcC, lcP;
    int u = F.bid, par = 0;
    if (u < NU) { const int lane = lane0, fr = lane & 15, kq = lane >> 4, tau = lane >> 2, q = lane & 3, hc = 64 * h + 8 * q; PREP_DMA(u, 0); PREP_LDR(u); }
    bool first = true;
    for (; u < NU; u += F.G, par ^= 1) {
        int lane = lane0; asm volatile("" : "+v"(lane));
        const int fr = lane & 15, kq = lane >> 4, tau = lane >> 2, q = lane & 3, hc = 64 * h + 8 * q;
        const int b = u >> 7, t0 = (u & 127) * 16, tok0 = u * 16, un = u + F.G;
        const size_t tok = (size_t)tok0 + tau; const int tpos = t0 + tau; const bool hp = tpos > 0;
        if (first) asm volatile("s_waitcnt vmcnt(0)" ::: "memory"); else asm volatile("s_waitcnt vmcnt(6)" ::: "memory");
        first = false;
        LDS_BARRIER();
        bf16x8 Bw[4][2], Ba[4][2], Bg[4][4], Bv[4][1];
        PREP_LDB(Bw, dupT, 64, 2);
        if (un < NU) PREP_DMA(un, par ^ 1);
        const LAS bf16* ZS = (const LAS bf16*)(F.lds + par * ZBUF);
        LAS float* MAc = (LAS float*)(F.lds + MA_OFF + par * 2048);
        { float x[16]; unpack8(aq0, *(float(*)[8])&x[0]); unpack8(aq1, *(float(*)[8])&x[8]);
          float s = 0.f;
#pragma unroll
          for (int i = 0; i < 16; ++i) s += x[i] * x[i];
          s = red4(s); const float r = 0.125f / sqrtf(s * (1.0f / 64.0f) + NORM_EPS);
          float gq[16]; PT16(PT_QG + 8 * q, gq);
#pragma unroll
          for (int i = 0; i < 16; ++i) x[i] = x[i] * r * gq[i];
          bf16* o = QN + (((size_t)b * NH + h) * SEQ + tpos) * 64 + 8 * q; ST16(o, x); }
        { float x[16]; unpack8(ak0, *(float(*)[8])&x[0]); unpack8(ak1, *(float(*)[8])&x[8]);
          float s = 0.f;
#pragma unroll
          for (int i = 0; i < 16; ++i) s += x[i] * x[i];
          s = red4(s); const float r = 1.0f / sqrtf(s * (1.0f / 64.0f) + NORM_EPS);
          float gk[16]; PT16(PT_KG + 8 * q, gk);
#pragma unroll
          for (int i = 0; i < 16; ++i) x[i] = x[i] * r * gk[i];
          bf16* o = KN + (((size_t)b * NH + h) * SEQ + tpos) * 64 + 8 * q; ST16(o, x); }
        { const unsigned vw[8] = {av0.x, av0.y, av0.z, av0.w, av1.x, av1.y, av1.z, av1.w};
          const int hh = (tau >> 2) & 1, jj = 4 * (tau >> 3) + (tau & 3);
          LAS bf16* sT = sW;
#pragma unroll
          for (int i = 0; i < 16; ++i) { const int d = 8 * q + (i & 7) + 32 * (i >> 3); sT[(hh * 64 + d) * 8 + jj] = (bf16)((i & 1) ? (vw[i >> 1] >> 16) : (vw[i >> 1] & 0xffffu)); }
          LDS_WAIT(); asm volatile("" ::: "memory");
          const u32x4 o0 = *(const LAS u32x4*)(sT + 8 * lane), o1 = *(const LAS u32x4*)(sT + 512 + 8 * lane);
          bf16* o = VF + ((((size_t)b * NH + h) * 128 + (tpos >> 4)) * 1024) + 8 * lane;
          *(u32x4*)o = o0; *(u32x4*)(o + 512) = o1;
          LDS_WAIT(); asm volatile("" ::: "memory"); }
        { float c_[8], p_[8], m_[8], x[8]; unpack8(lcC, c_); unpack8(lcP, p_); lds8f(PT + PT_MU + 1536 + 32 * h + 8 * kq, m_); const bool hpf = (t0 + fr) > 0;
#pragma unroll
          for (int i = 0; i < 8; ++i) { const float pp = hpf ? p_[i] : 0.f; x[i] = c_[i] + (pp - c_[i]) * m_[i]; x[i] = h < 2 ? ftanh(x[i]) : (h < 4 ? x[i] : fsigmoid(x[i])); }
          *(LAS u32x4*)(AF + fr * AFROW + 32 * h + 8 * kq) = __builtin_bit_cast(u32x4, pack8(x)); }
        if (l == 1) {
            f32x4 m0 = (f32x4){0.f, 0.f, 0.f, 0.f}, m1 = m0;
#pragma unroll
            for (int k2 = 0; k2 < 2; ++k2) { const int ks = 2 * h + k2; float x[8]; ZSH8(fr, (t0 + fr) > 0, 1024 + 32 * ks + 8 * kq, x); const bf16x8 a = pack8(x);
                m0 = __builtin_amdgcn_mfma_f32_16x16x32_bf16(a, *(const bf16x8*)(vrdT + (size_t)fr * DR + 32 * ks + 8 * kq), m0, 0, 0, 0);
                m1 = __builtin_amdgcn_mfma_f32_16x16x32_bf16(a, *(const bf16x8*)(vrdT + (size_t)(16 + fr) * DR + 32 * ks + 8 * kq), m1, 0, 0, 0); }
#pragma unroll
            for (int j = 0; j < 4; ++j) {
                LDS_IADD((LAS int*)MAc + (4 * kq + j) * 32 + fr, (int)__builtin_rintf(__builtin_amdgcn_fmed3f(m0[j], -8000.f, 8000.f) * 262144.f));
                LDS_IADD((LAS int*)MAc + (4 * kq + j) * 32 + 16 + fr, (int)__builtin_rintf(__builtin_amdgcn_fmed3f(m1[j], -8000.f, 8000.f) * 262144.f)); }
        }
        if (un < NU) PREP_LDR(un);
        PREP_LDB(Ba, iupT, 64, 2);
        LDS_BARRIER();
        u32x4 vf0, vf1;
        if (l == 1) { vf0 = ldg16(VFIRST + tok * DR + hc); vf1 = ldg16(VFIRST + tok * DR + hc + 32);
            if (F.wave == 0) { LAS f32x4* z = (LAS f32x4*)(F.lds + MA_OFF + (par ^ 1) * 2048); z[lane] = (f32x4){0.f, 0.f, 0.f, 0.f}; z[64 + lane] = (f32x4){0.f, 0.f, 0.f, 0.f}; } }
        bf16* op = OPS + ((((size_t)b * NH + h) * (SEQ / 16) + (tpos >> 4)) * 7) * 1024 + (tpos & 15) * 32 + 8 * q;
        float k16[16]; ZSH16(tau, hp, 512 + hc, k16);
        float kinv;
        { float kk16[16]; PT16(PT_KK + hc, kk16); float ssq = 0.f;
#pragma unroll
          for (int i = 0; i < 16; ++i) { const float t = k16[i] * kk16[i]; ssq += t * t; }
          ssq = red4(ssq); kinv = 1.0f / fmaxf(sqrtf(ssq), 1e-12f); }
        { PREP_LORA(Bw, 0, 2); float wl[16], p0[16]; SW16(wl); PT16(PT_DW0 + hc, p0);
#pragma unroll
          for (int i = 0; i < 16; ++i) wl[i] = -0.60653066f * fsigmoid(wl[i] + p0[i]);
          ST16O(op + 1 * 1024, wl); }
        u32x4 K4a, K4b, K5a, K5b, G6a, G6b;
        { PREP_LORA(Ba, 64, 2); PREP_LDB(Bg, gupT, 128, 4); float al[16], p1[16], p3[16], o[16]; SW16(al); PT16(PT_IA0 + hc, p1); PT16(PT_KA + hc, p3);
#pragma unroll
          for (int i = 0; i < 16; ++i) { al[i] = fsigmoid(al[i] + p1[i]); o[i] = k16[i] * (1.0f + (al[i] - 1.0f) * p3[i]); }
          ST16O(op + 2 * 1024, o);
          { float r16[16]; ZSH16(tau, hp, hc, r16); ST16O(op + 0 * 1024, r16); PT16(PT_RK + hc, p3);
            float bs = 0.f;
#pragma unroll
            for (int i = 0; i < 16; ++i) bs += r16[i] * o[i] * p3[i];
            bs = red4(bs); if (q == 0) BON[((size_t)b * NH + h) * SEQ + tpos] = bs; }
#pragma unroll
          PT16(PT_KK + hc, p1);
#pragma unroll
          for (int i = 0; i < 16; ++i) { o[i] = k16[i] * p1[i] * kinv; al[i] = o[i] * al[i]; }
          K4a = __builtin_bit_cast(u32x4, pack8(*(const float(*)[8])&o[0])); K4b = __builtin_bit_cast(u32x4, pack8(*(const float(*)[8])&o[8]));
          K5a = __builtin_bit_cast(u32x4, pack8(*(const float(*)[8])&al[0])); K5b = __builtin_bit_cast(u32x4, pack8(*(const float(*)[8])&al[8])); }
        { PREP_LORA(Bg, 128, 4); if (l == 1) PREP_LDB(Bv, vruT, 32, 1); G6a = *(const LAS u32x4*)(sW + tau * 64 + 8 * q); G6b = *(const LAS u32x4*)(sW + tau * 64 + 8 * q + 32); }
        { float v16[16]; ZSH16(tau, hp, 1024 + hc, v16);
          if (l == 1) {
              float am8[8]; { const i32x4 a0 = *(const LAS i32x4*)(MAc + fr * 32 + 8 * kq), a1 = *(const LAS i32x4*)(MAc + fr * 32 + 8 * kq + 4);
#pragma unroll
                  for (int i = 0; i < 4; ++i) { am8[i] = (float)a0[i] * (1.0f / 262144.f); am8[4 + i] = (float)a1[i] * (1.0f / 262144.f); } }
              const bf16x8 am = pack8(am8);
#pragma unroll
              for (int nb = 0; nb < 4; ++nb) {
                  const f32x4 avr = __builtin_amdgcn_mfma_f32_16x16x32_bf16(am, Bv[nb][0], (f32x4){0.f, 0.f, 0.f, 0.f}, 0, 0, 0);
#pragma unroll
                  for (int j = 0; j < 4; ++j) sW[(4 * kq + j) * 64 + 16 * nb + fr] = (bf16)(cvt_pk_bf16(avr[j], 0.f) & 0xffffu); }
              LDS_WAIT(); asm volatile("" ::: "memory");
              float vl[16], vb[16], vf[16]; SW16(vl); PT16(PT_VRB + hc, vb); unpack8(vf0, *(float(*)[8])&vf[0]); unpack8(vf1, *(float(*)[8])&vf[8]);
#pragma unroll
              for (int i = 0; i < 16; ++i) v16[i] = v16[i] + (vf[i] - v16[i]) * fsigmoid(vb[i] + vl[i]);
          } else { ST16(VFIRST + tok * DR + hc, v16); }
          ST16O(op + 3 * 1024, v16); }
        asm volatile("" ::: "memory");
        *(u32x4*)(op + 4 * 1024) = K4a; *(u32x4*)(op + 4 * 1024 + 512) = K4b; *(u32x4*)(op + 5 * 1024) = K5a; *(u32x4*)(op + 5 * 1024 + 512) = K5b; *(u32x4*)(op + 6 * 1024) = G6a; *(u32x4*)(op + 6 * 1024 + 512) = G6b;
        asm volatile("" ::: "memory");
    }
#undef PREP_DMA
#undef PREP_LDR
#undef ZSH8
#undef ZSH16
#undef PREP_LORA
#undef PREP_LDB
#undef SW16
#undef PT16
#undef ST16
#undef ST16O
}

__device__ __forceinline__ NOPK void rec_phase(Frame& F, const Args& A, int l) {
    const bf16* OPS = (const bf16*)(F.ws + WS_OPS); bf16* YC = (bf16*)(F.ws + WS_YCAT);
    constexpr int TCH = 32, BUF_F = 7 * TCH * 64;
    LAS float* buf = (LAS float*)F.lds; LAS float* ybuf = (LAS float*)(F.lds + 2 * BUF_F * 4);
    const int v0 = 8 * F.wave + 2 * (F.lane >> 4), seg = F.lane & 15;
    for (int bh = F.bid; bh < BATCH * NH; bh += F.G) {
        const int b = bh >> 3, h = bh & 7;
        const bf16* src = OPS + (size_t)bh * SEQ * 448;
        f32x4 S0 = (f32x4){0.f, 0.f, 0.f, 0.f}, S1 = S0;
        u32x4 pre[4];
#define REC_ISSUE(c_) do { _Pragma("unroll") for (int i_ = 0; i_ < 4; ++i_) { const int p_ = F.tid + 512 * i_; if (p_ < 1792) pre[i_] = *(const u32x4*)(src + (size_t)(c_) * TCH * 448 + 8 * p_); } } while (0)
#define REC_LAND(c_) do { LAS float* d_ = buf + ((c_) & 1) * BUF_F; _Pragma("unroll") for (int i_ = 0; i_ < 4; ++i_) { const int p_ = F.tid + 512 * i_; if (p_ < 1792) { const int e0_ = 8 * p_, st_ = e0_ / 448, rem_ = e0_ % 448, arr_ = rem_ >> 6, col_ = rem_ & 63; \
            float f_[8]; unpack8(pre[i_], f_); LAS float* o_ = d_ + (arr_ * TCH + st_) * 64 + col_; *(LAS f32x4*)o_ = (f32x4){f_[0], f_[1], f_[2], f_[3]}; *(LAS f32x4*)(o_ + 4) = (f32x4){f_[4], f_[5], f_[6], f_[7]}; } } } while (0)
#define REC_LD(s_, KK, W, BB, KQ, RQ, VV) do { const LAS float* q_ = B + (s_) * 64 + 4 * seg; RQ = *(const LAS f32x4*)(q_); W = *(const LAS f32x4*)(q_ + 1 * TCH * 64); KQ = *(const LAS f32x4*)(q_ + 2 * TCH * 64); \
            KK = *(const LAS f32x4*)(q_ + 4 * TCH * 64); BB = *(const LAS f32x4*)(q_ + 5 * TCH * 64); VV = *(const LAS f32x2*)(B + (3 * TCH + (s_)) * 64 + v0); } while (0)
        const f32x4 rk = *(const f32x4*)(A.in[I_RK] + (size_t)l * DR + 64 * h + 4 * (F.tid & 15)), lw = *(const f32x4*)(A.in[I_LNW] + (size_t)l * DR + 64 * h + 4 * (F.tid & 15)), lb = *(const f32x4*)(A.in[I_LNB] + (size_t)l * DR + 64 * h + 4 * (F.tid & 15));
        REC_ISSUE(0); REC_LAND(0); LDS_BARRIER();
        for (int c = 0; c < SEQ / TCH; ++c) {
            if (c + 1 < SEQ / TCH) REC_ISSUE(c + 1);
            const LAS float* B = buf + (c & 1) * BUF_F;
            f32x4 kk, w, bb, kq, rq; f32x2 vv;
            REC_LD(0, kk, w, bb, kq, rq, vv);
#pragma unroll 4
            for (int s = 0; s < TCH; ++s) {
                f32x4 nkk, nw, nbb, nkq, nrq; f32x2 nvv;
                { const int sn = (s + 1 < TCH) ? s + 1 : s; REC_LD(sn, nkk, nw, nbb, nkq, nrq, nvv); }
                float p0 = (S0.x * kk.x + S0.y * kk.y) + (S0.z * kk.z + S0.w * kk.w);
                float p1 = (S1.x * kk.x + S1.y * kk.y) + (S1.z * kk.z + S1.w * kk.w);
                const f32x4 u0 = S0 * w + vv.x * kq, u1 = S1 * w + vv.y * kq;
                float U0 = (u0.x * rq.x + u0.y * rq.y) + (u0.z * rq.z + u0.w * rq.w);
                float U1 = (u1.x * rq.x + u1.y * rq.y) + (u1.z * rq.z + u1.w * rq.w);
                float Br = (bb.x * rq.x + bb.y * rq.y) + (bb.z * rq.z + bb.w * rq.w);
                p0 = red16(p0); p1 = red16(p1); U0 = red16(U0); U1 = red16(U1); Br = red16(Br);
                S0 = u0 - p0 * bb; S1 = u1 - p1 * bb;
                if (seg == 0) *(LAS f32x2*)(ybuf + s * 64 + v0) = (f32x2){U0 - p0 * Br, U1 - p1 * Br};
                kk = nkk; w = nw; bb = nbb; kq = nkq; rq = nrq; vv = nvv;
            }
            LDS_BARRIER();
            {
                const int st = F.tid >> 4, part = F.tid & 15, c4 = 4 * part;
                const f32x4 y4 = *(const LAS f32x4*)(ybuf + st * 64 + c4);
                const float mean = red16((y4.x + y4.y) + (y4.z + y4.w)) * (1.0f / 64.0f);
                const f32x4 dv = y4 - mean;
                const float var = red16((dv.x * dv.x + dv.y * dv.y) + (dv.z * dv.z + dv.w * dv.w)) * (1.0f / 64.0f);
                const float rstd = 1.0f / sqrtf(var + GN_EPS);
                const f32x4 r4 = *(const LAS f32x4*)(B + (0 * TCH + st) * 64 + c4), k4 = *(const LAS f32x4*)(B + (2 * TCH + st) * 64 + c4), v4 = *(const LAS f32x4*)(B + (3 * TCH + st) * 64 + c4), g4 = *(const LAS f32x4*)(B + (6 * TCH + st) * 64 + c4);
                const float bon = red16((r4.x * k4.x * rk.x + r4.y * k4.y * rk.y) + (r4.z * k4.z * rk.z + r4.w * k4.w * rk.w));
                const f32x4 o = (dv * rstd * lw + lb + bon * v4) * g4;
                u32x2 w; w.x = cvt_pk_bf16(o.x, o.y); w.y = cvt_pk_bf16(o.z, o.w);
                *(u32x2*)(YC + ((size_t)b * SEQ + c * TCH + st) * D + 64 * h + c4) = w;
            }
            if (c + 1 < SEQ / TCH) REC_LAND(c + 1);
            LDS_BARRIER();
        }
    }
}

__device__ __forceinline__ NOPK void attn_waves(Frame& F, const Args& A, int l, int wu0, int wustride) {
    const bf16* QN = (const bf16*)(F.ws + WS_QN); const bf16* KN = (const bf16*)(F.ws + WS_KN); const bf16* VF = (const bf16*)(F.ws + WS_VF); bf16* YC = (bf16*)(F.ws + WS_YCAT);
    const int qi = F.lane & 31, hh = F.lane >> 5;
    LAS unsigned char* stg = F.lds + 4 * 33536 + (F.wave - 4) * 4352;
    for (int wu = wu0; wu < BATCH * NH * 64; wu += wustride) {
        const int bh = wu >> 6, b = bh >> 3, h = bh & 7;
        const int Q0 = 32 * (wu & 63);
        bf16x8 qf[4];
#pragma unroll
        for (int ks = 0; ks < 4; ++ks) qf[ks] = *(const bf16x8*)(QN + ((size_t)bh * SEQ + Q0 + qi) * 64 + 16 * ks + 8 * hh);
        f32x16 O0, O1;
#pragma unroll
        for (int i = 0; i < 16; ++i) { O0[i] = 0.f; O1[i] = 0.f; }
        float R = 1.f;
        const int kbd = Q0 >> 5;
        for (int kb = kbd; kb >= 0; --kb) {
            bf16x8 kf[4], vf[2][2];
#pragma unroll
            for (int ks = 0; ks < 4; ++ks) kf[ks] = *(const bf16x8*)(KN + ((size_t)bh * SEQ + 32 * kb + qi) * 64 + 16 * ks + 8 * hh);
#pragma unroll
            for (int s = 0; s < 2; ++s)
#pragma unroll
                for (int db = 0; db < 2; ++db) vf[s][db] = *(const bf16x8*)(VF + ((((size_t)bh * 128 + 2 * kb + s) * 2 + hh) * 64 + qi + 32 * db) * 8);
            f32x16 Sx;
#pragma unroll
            for (int i = 0; i < 16; ++i) Sx[i] = 0.f;
#pragma unroll
            for (int ks = 0; ks < 4; ++ks) Sx = __builtin_amdgcn_mfma_f32_32x32x16_bf16(kf[ks], qf[ks], Sx, 0, 0, 0);
            const bool diag = (kb == kbd);
            float kp[16], sg[16];
#pragma unroll
            for (int i = 0; i < 16; ++i) { const int rho = (i & 3) + 8 * (i >> 2) + 4 * hh; const bool valid = !diag || rho < qi; const float L = Sx[i];
                const float e = __builtin_amdgcn_exp2f(-1.44269504f * fabsf(L)), r = __builtin_amdgcn_rcpf(1.0f + e), er = e * r; const bool pos = L >= 0.f;
                kp[i] = valid ? (pos ? er : r) : 1.f; sg[i] = valid ? (pos ? r : er) : 0.f; }
            float Cx[16], G[4], Pg[4];
#pragma unroll
            for (int gi = 0; gi < 4; ++gi) { const float x2 = kp[4 * gi + 3], x1 = x2 * kp[4 * gi + 2], x0 = x1 * kp[4 * gi + 1]; Cx[4 * gi + 3] = 1.f; Cx[4 * gi + 2] = x2; Cx[4 * gi + 1] = x1; Cx[4 * gi] = x0; G[gi] = x0 * kp[4 * gi]; }
#pragma unroll
            for (int gi = 0; gi < 4; ++gi) Pg[gi] = __shfl_xor(G[gi], 32);
            float T[4]; { const float sa2 = G[3], sa1 = sa2 * G[2], sa0 = sa1 * G[1], sb2 = Pg[3], sb1 = sb2 * Pg[2], sb0 = sb1 * Pg[1];
                T[3] = 1.f; T[2] = sa2 * sb2; T[1] = sa1 * sb1; T[0] = sa0 * sb0;
                if (hh == 0) { T[3] *= Pg[3]; T[2] *= Pg[2]; T[1] *= Pg[1]; T[0] *= Pg[0]; } }
            const float tot = ((G[0] * G[1]) * (G[2] * G[3])) * ((Pg[0] * Pg[1]) * (Pg[2] * Pg[3]));
            float wg[16];
#pragma unroll
            for (int i = 0; i < 16; ++i) wg[i] = sg[i] * Cx[i] * (T[i >> 2] * R);
            R *= tot;
            const bf16x8 p0 = pack8(*(float(*)[8])&wg[0]), p1 = pack8(*(float(*)[8])&wg[8]);
            O0 = __builtin_amdgcn_mfma_f32_32x32x16_bf16(vf[0][0], p0, O0, 0, 0, 0); O1 = __builtin_amdgcn_mfma_f32_32x32x16_bf16(vf[0][1], p0, O1, 0, 0, 0);
            O0 = __builtin_amdgcn_mfma_f32_32x32x16_bf16(vf[1][0], p1, O0, 0, 0, 0); O1 = __builtin_amdgcn_mfma_f32_32x32x16_bf16(vf[1][1], p1, O1, 0, 0, 0);
            if (__all(R < 9.3576e-14f)) break;
        }
        float ss = 0.f;
#pragma unroll
        for (int i = 0; i < 16; ++i) ss += O0[i] * O0[i] + O1[i] * O1[i];
        ss += __shfl_xor(ss, 32);
        const float rstd = 1.0f / sqrtf(ss * (1.0f / 64.0f) + NORM_EPS);
        const float* og = A.in[I_SBG] + (size_t)l * DR + 64 * h;
#pragma unroll
        for (int db = 0; db < 2; ++db)
#pragma unroll
            for (int gi = 0; gi < 4; ++gi) { const int d = 32 * db + 8 * gi + 4 * hh; const f32x4 gq = *(const f32x4*)(og + d);
                const float o0 = (db ? O1[4 * gi] : O0[4 * gi]) * rstd * gq.x, o1 = (db ? O1[4 * gi + 1] : O0[4 * gi + 1]) * rstd * gq.y, o2 = (db ? O1[4 * gi + 2] : O0[4 * gi + 2]) * rstd * gq.z, o3 = (db ? O1[4 * gi + 3] : O0[4 * gi + 3]) * rstd * gq.w;
                u32x2 w; w.x = cvt_pk_bf16(o0, o1); w.y = cvt_pk_bf16(o2, o3); *(LAS u32x2*)(stg + qi * 136 + d * 2) = w; }
        LDS_WAIT(); asm volatile("" ::: "memory");
#pragma unroll
        for (int k = 0; k < 4; ++k) { const int row = 8 * k + (F.lane >> 3), un8 = F.lane & 7;
            const u32x2 lo_ = *(const LAS u32x2*)(stg + row * 136 + un8 * 16), hi_ = *(const LAS u32x2*)(stg + row * 136 + un8 * 16 + 8);
            *(u32x4*)(YC + ((size_t)b * SEQ + Q0 + row) * D + 512 + 64 * h + un8 * 8) = (u32x4){lo_.x, lo_.y, hi_.x, hi_.y}; }
        LDS_WAIT(); asm volatile("" ::: "memory");
    }
}

constexpr int CL = 32, NCH = SEQ / CL, CH_ELEMS = 12288;
constexpr size_t WS_CH = WS_Z;
#define CH_SWZ(row, col) (((((col) >> 3) ^ ((row) & 7)) << 3) | ((col) & 7))
constexpr int C1_LDS = 33536; static_assert(4 * C1_LDS + 4 * 4352 <= MISC_OFF, "c1 + attention staging LDS");
__device__ __forceinline__ NOPK bf16x8 acc_frag(const f32x16& a, int s) {
    float f[8];
#pragma unroll
    for (int i = 0; i < 8; ++i) f[i] = a[8 * s + i];
    return pack8(f);
}
__device__ __forceinline__ NOPK void c1_unit(Frame& F, int l, int bh, int c, LAS unsigned char* wl) {
    const bf16* OPS = (const bf16*)(F.ws + WS_OPS) + ((size_t)bh * SEQ + (size_t)c * CL) * 448;
    bf16* CH = (bf16*)(F.ws + WS_CH) + ((size_t)bh * NCH + c) * CH_ELEMS;
    constexpr int IP = 40, RP = 72, TP = 72;
    LAS bf16* KT = (LAS bf16*)wl; LAS bf16* VT = KT + 64 * IP; LAS bf16* KbT = VT + 64 * IP; LAS bf16* BbT = KbT + 64 * IP;
    LAS bf16* RtI = BbT + 64 * IP; LAS bf16* WvI = RtI + 32 * RP; LAS bf16* XI = WvI + 64 * IP; LAS float* cLs = (LAS float*)(WvI + 4096);
    LAS float* TB = (LAS float*)WvI;
    const int lane = F.lane, t = lane & 31, h = lane >> 5;
    const int trq = (lane & 15) >> 2, trp = lane & 3, trb = (lane >> 4) & 1;
#pragma unroll
    for (int n = 0; n < 4; ++n) { float w8[8]; unpack8(*(const u32x4*)(OPS + (t >> 4) * 7168 + 1 * 1024 + (n >> 1) * 512 + (t & 15) * 32 + 8 * (h + 2 * (n & 1))), w8);
        *(LAS f32x4*)(TB + t * 64 + 8 * (h + 2 * n)) = (f32x4){w8[0], w8[1], w8[2], w8[3]}; *(LAS f32x4*)(TB + t * 64 + 8 * (h + 2 * n) + 4) = (f32x4){w8[4], w8[5], w8[6], w8[7]}; }
    u32x4 rw[5][4];
#pragma unroll
    for (int a = 0; a < 5; ++a)
#pragma unroll
        for (int n = 0; n < 4; ++n) rw[a][n] = *(const u32x4*)(OPS + (t >> 4) * 7168 + (a == 0 ? 0 : a + 1) * 1024 + (n >> 1) * 512 + (t & 15) * 32 + 8 * (h + 2 * (n & 1)));
    LDS_WAIT(); asm volatile("" ::: "memory");
    float cLl;
    { float cs = 0.f;
#pragma unroll 8
      for (int s = 0; s < CL; ++s) { cs += TB[s * 64 + lane]; TB[s * 64 + lane] = cs; }
      cLl = cs; }
    LDS_WAIT(); asm volatile("" ::: "memory");
    bf16x8 fKap[4], fBt[4], fKt[4], fRt[4];
#pragma unroll
    for (int n = 0; n < 4; ++n) { const int j0 = 8 * (h + 2 * n);
        float ct[8], cl[8]; lds8f(TB + t * 64 + j0, ct); lds8f(TB + 31 * 64 + j0, cl);
        float r8[8], k8[8], ka8[8], be8[8], x[8];
        unpack8(rw[0][n], r8); unpack8(rw[1][n], k8); unpack8(rw[3][n], ka8); unpack8(rw[4][n], be8);
        float ep[8], en[8], ed[8], eq[8];
#pragma unroll
        for (int i = 0; i < 8; ++i) { ep[i] = __expf(ct[i]); en[i] = __expf(-ct[i]); ed[i] = __expf(cl[i] - ct[i]);
            const float sh_ = __int_as_float(__builtin_amdgcn_update_dpp(0, __float_as_int(ep[i]), 0x138, 0xf, 0xf, false));
            eq[i] = t > 0 ? sh_ : 1.0f; }
#pragma unroll
        for (int i = 0; i < 8; ++i) x[i] = ka8[i] * eq[i];
        fKap[n] = pack8(x); *(LAS u32x4*)(KT + t * TP + j0) = __builtin_bit_cast(u32x4, fKap[n]);
#pragma unroll
        for (int i = 0; i < 8; ++i) x[i] = be8[i] * en[i];
        fBt[n] = pack8(x);
#pragma unroll
        for (int i = 0; i < 8; ++i) x[i] = k8[i] * en[i];
        fKt[n] = pack8(x);
#pragma unroll
        for (int i = 0; i < 8; ++i) x[i] = r8[i] * ep[i];
        fRt[n] = pack8(x); *(LAS u32x4*)(RtI + t * RP + j0) = __builtin_bit_cast(u32x4, fRt[n]);
        *(LAS u32x4*)(VT + t * TP + j0) = rw[2][n];
#pragma unroll
        for (int i = 0; i < 8; ++i) x[i] = k8[i] * ed[i];
        *(LAS u32x4*)(KbT + t * TP + j0) = __builtin_bit_cast(u32x4, pack8(x));
#pragma unroll
        for (int i = 0; i < 8; ++i) x[i] = be8[i] * ed[i];
        *(LAS u32x4*)(BbT + t * TP + j0) = __builtin_bit_cast(u32x4, pack8(x));
        asm volatile("" ::: "memory"); }
    LDS_WAIT(); asm volatile("" ::: "memory");
    cLs[lane] = cLl;
    LDS_WAIT(); asm volatile("" ::: "memory");
    const f32x16 Z16 = {0.f, 0.f, 0.f, 0.f, 0.f, 0.f, 0.f, 0.f, 0.f, 0.f, 0.f, 0.f, 0.f, 0.f, 0.f, 0.f};
#define C1_ROW(i) (((i) & 3) + 8 * ((i) >> 2) + 4 * h)
#define C1_PUT(IMG, PITCH, ROW0, ACC) do { _Pragma("unroll") for (int g_ = 0; g_ < 4; ++g_) { u32x2 w_; w_.x = cvt_pk_bf16(ACC[4 * g_], ACC[4 * g_ + 1]); w_.y = cvt_pk_bf16(ACC[4 * g_ + 2], ACC[4 * g_ + 3]); \
        *(LAS u32x2*)(IMG + t * (PITCH) + (ROW0) + 8 * g_ + 4 * h) = w_; } LDS_WAIT(); asm volatile("" ::: "memory"); } while (0)
#define C1_TR(P_) __builtin_amdgcn_ds_read_tr16_b64_v4i16((LAS s16x4*)(P_))
#define C1_GETA(IMG, PITCH, ROW0, ks) ({ LAS bf16* b_ = (LAS bf16*)(IMG) + (16 * (ks) + 4 * h + trq) * (PITCH) + (ROW0) + 16 * trb + 4 * trp; const s16x4 lo_ = C1_TR(b_), hi_ = C1_TR(b_ + 8 * (PITCH)); \
        (bf16x8){lo_.x, lo_.y, lo_.z, lo_.w, hi_.x, hi_.y, hi_.z, hi_.w}; })
    f32x16 P = Z16;
#pragma unroll
    for (int ks = 0; ks < 4; ++ks) P = __builtin_amdgcn_mfma_f32_32x32x16_bf16(fBt[ks], fKap[ks], P, 0, 0, 0);
    f32x16 T;
#pragma unroll
    for (int i = 0; i < 16; ++i) { const int row = C1_ROW(i); P[i] = row < t ? -P[i] : 0.f; T[i] = P[i] + (row == t ? 1.f : 0.f); }
    C1_PUT(XI, IP, 0, P);
    bf16x8 aP0 = C1_GETA(XI, IP, 0, 0), aP1 = C1_GETA(XI, IP, 0, 1);
    LDS_WAIT(); asm volatile("" ::: "memory");
#pragma unroll 1
    for (int it = 0; it < 4; ++it) {
        const bf16x8 bP0 = acc_frag(P, 0), bP1 = acc_frag(P, 1);
        P = __builtin_amdgcn_mfma_f32_32x32x16_bf16(aP0, bP0, Z16, 0, 0, 0); P = __builtin_amdgcn_mfma_f32_32x32x16_bf16(aP1, bP1, P, 0, 0, 0);
        C1_PUT(XI, IP, 0, P);
        aP0 = C1_GETA(XI, IP, 0, 0); aP1 = C1_GETA(XI, IP, 0, 1);
        LDS_WAIT(); asm volatile("" ::: "memory");
        const bf16x8 bT0 = acc_frag(T, 0), bT1 = acc_frag(T, 1);
        T = __builtin_amdgcn_mfma_f32_32x32x16_bf16(aP0, bT0, T, 0, 0, 0); T = __builtin_amdgcn_mfma_f32_32x32x16_bf16(aP1, bT1, T, 0, 0, 0);
    }
    const bf16x8 bT0 = acc_frag(T, 0), bT1 = acc_frag(T, 1);
    f32x16 Akk = Z16, Qkr = Z16, Qbr = Z16;
#pragma unroll
    for (int ks = 0; ks < 4; ++ks) { Akk = __builtin_amdgcn_mfma_f32_32x32x16_bf16(fKt[ks], fKap[ks], Akk, 0, 0, 0); Qkr = __builtin_amdgcn_mfma_f32_32x32x16_bf16(fKt[ks], fRt[ks], Qkr, 0, 0, 0);
                                    Qbr = __builtin_amdgcn_mfma_f32_32x32x16_bf16(fBt[ks], fRt[ks], Qbr, 0, 0, 0); }
#pragma unroll
    for (int i = 0; i < 16; ++i) { const int row = C1_ROW(i); Akk[i] = row < t ? Akk[i] : 0.f; Qkr[i] = row <= t ? Qkr[i] : 0.f; Qbr[i] = row <= t ? Qbr[i] : 0.f; }
    const bf16x8 bQkr0 = acc_frag(Qkr, 0), bQkr1 = acc_frag(Qkr, 1), bQbr0 = acc_frag(Qbr, 0), bQbr1 = acc_frag(Qbr, 1);
    C1_PUT(XI, IP, 0, Akk);
    bf16x8 bM0, bM1;
    { const bf16x8 a0 = C1_GETA(XI, IP, 0, 0), a1 = C1_GETA(XI, IP, 0, 1);
      f32x16 M1 = __builtin_amdgcn_mfma_f32_32x32x16_bf16(a0, bT0, Z16, 0, 0, 0); M1 = __builtin_amdgcn_mfma_f32_32x32x16_bf16(a1, bT1, M1, 0, 0, 0);
      bM0 = acc_frag(M1, 0); bM1 = acc_frag(M1, 1); }
    bf16x8 aKh[2][2];
    { const bf16x8 a00 = C1_GETA(KT, TP, 0, 0), a01 = C1_GETA(KT, TP, 0, 1), a10 = C1_GETA(KT, TP, 32, 0), a11 = C1_GETA(KT, TP, 32, 1);
      LDS_WAIT(); asm volatile("" ::: "memory");
      f32x16 k0 = __builtin_amdgcn_mfma_f32_32x32x16_bf16(a00, bT0, Z16, 0, 0, 0); k0 = __builtin_amdgcn_mfma_f32_32x32x16_bf16(a01, bT1, k0, 0, 0, 0);
      f32x16 k1 = __builtin_amdgcn_mfma_f32_32x32x16_bf16(a10, bT0, Z16, 0, 0, 0); k1 = __builtin_amdgcn_mfma_f32_32x32x16_bf16(a11, bT1, k1, 0, 0, 0);
      C1_PUT(KT, TP, 0, k0); C1_PUT(KT, TP, 32, k1);
#pragma unroll
      for (int jb = 0; jb < 2; ++jb)
#pragma unroll
          for (int ks = 0; ks < 2; ++ks) aKh[jb][ks] = C1_GETA(KT, TP, 32 * jb, ks); }
    bf16x8 aVT[2][2], aWv[2][2];
#pragma unroll
    for (int vb = 0; vb < 2; ++vb)
#pragma unroll
        for (int ks = 0; ks < 2; ++ks) aVT[vb][ks] = C1_GETA(VT, TP, 32 * vb, ks);
    { f32x16 w0 = __builtin_amdgcn_mfma_f32_32x32x16_bf16(aVT[0][0], bM0, Z16, 0, 0, 0); w0 = __builtin_amdgcn_mfma_f32_32x32x16_bf16(aVT[0][1], bM1, w0, 0, 0, 0);
      f32x16 w1 = __builtin_amdgcn_mfma_f32_32x32x16_bf16(aVT[1][0], bM0, Z16, 0, 0, 0); w1 = __builtin_amdgcn_mfma_f32_32x32x16_bf16(aVT[1][1], bM1, w1, 0, 0, 0);
      C1_PUT(WvI, TP, 0, w0); C1_PUT(WvI, TP, 32, w1);
#pragma unroll
      for (int vb = 0; vb < 2; ++vb)
#pragma unroll
          for (int ks = 0; ks < 2; ++ks) aWv[vb][ks] = C1_GETA(WvI, TP, 32 * vb, ks); }
    LDS_WAIT(); asm volatile("" ::: "memory");
    LAS bf16* STG = (LAS bf16*)wl;
#define C1_ST4(BLK, ROWL, COL, a0_, a1_, a2_, a3_) do { u32x2 w_; w_.x = cvt_pk_bf16(a0_, a1_); w_.y = cvt_pk_bf16(a2_, a3_); *(LAS u32x2*)(STG + ((BLK) & 1) * 2048 + (ROWL) * 64 + CH_SWZ(ROWL, COL)) = w_; } while (0)
#define C1_FLUSH(BLK, GOFF) do { LDS_WAIT(); asm volatile("" ::: "memory"); _Pragma("unroll") for (int k_ = 0; k_ < 4; ++k_) { const u32x4 w_ = *(const LAS u32x4*)(STG + ((BLK) & 1) * 2048 + (k_ * 64 + lane) * 8); \
        *(u32x4*)(CH + (GOFF) + (k_ * 64 + lane) * 8) = w_; } } while (0)
#pragma unroll
    for (int jb = 0; jb < 2; ++jb) { f32x16 a = __builtin_amdgcn_mfma_f32_32x32x16_bf16(aKh[jb][0], bQbr0, Z16, 0, 0, 0); a = __builtin_amdgcn_mfma_f32_32x32x16_bf16(aKh[jb][1], bQbr1, a, 0, 0, 0);
#pragma unroll
        for (int g = 0; g < 4; ++g) { const int j0 = 32 * jb + 8 * g + 4 * h; const u32x2 rv = *(const LAS u32x2*)(RtI + t * RP + j0);
            C1_ST4(0, t, j0, bflo(rv.x) - a[4 * g], bfhi(rv.x) - a[4 * g + 1], bflo(rv.y) - a[4 * g + 2], bfhi(rv.y) - a[4 * g + 3]); } }
    C1_FLUSH(0, 8192);
#pragma unroll
    for (int vb = 0; vb < 2; ++vb) { f32x16 a = __builtin_amdgcn_mfma_f32_32x32x16_bf16(aVT[vb][0], bQkr0, Z16, 0, 0, 0); a = __builtin_amdgcn_mfma_f32_32x32x16_bf16(aVT[vb][1], bQkr1, a, 0, 0, 0);
        f32x16 s = __builtin_amdgcn_mfma_f32_32x32x16_bf16(aWv[vb][0], bQbr0, Z16, 0, 0, 0); s = __builtin_amdgcn_mfma_f32_32x32x16_bf16(aWv[vb][1], bQbr1, s, 0, 0, 0);
#pragma unroll
        for (int g = 0; g < 4; ++g) { const int v0 = 32 * vb + 8 * g + 4 * h; C1_ST4(1, t, v0, a[4 * g] - s[4 * g], a[4 * g + 1] - s[4 * g + 1], a[4 * g + 2] - s[4 * g + 2], a[4 * g + 3] - s[4 * g + 3]); } }
    C1_FLUSH(1, 10240);
#pragma unroll
    for (int jc = 0; jc < 2; ++jc) { const bf16x8 bB0 = C1_GETA(BbT, TP, 32 * jc, 0), bB1 = C1_GETA(BbT, TP, 32 * jc, 1), bK0 = C1_GETA(KbT, TP, 32 * jc, 0), bK1 = C1_GETA(KbT, TP, 32 * jc, 1);
        const int jp = 32 * jc + t; const float gl = __expf(cLs[jp]);
#pragma unroll
        for (int jb = 0; jb < 2; ++jb) { f32x16 a = __builtin_amdgcn_mfma_f32_32x32x16_bf16(aKh[jb][0], bB0, Z16, 0, 0, 0); a = __builtin_amdgcn_mfma_f32_32x32x16_bf16(aKh[jb][1], bB1, a, 0, 0, 0);
#pragma unroll
            for (int g = 0; g < 4; ++g) { const int j0 = 32 * jb + 8 * g + 4 * h; float o[4];
#pragma unroll
                for (int e = 0; e < 4; ++e) o[e] = ((j0 + e) == jp ? gl : 0.f) - a[4 * g + e];
                C1_ST4(0, t, j0, o[0], o[1], o[2], o[3]); } }
        C1_FLUSH(0, jc * 2048);
#pragma unroll
        for (int vb = 0; vb < 2; ++vb) { f32x16 a = __builtin_amdgcn_mfma_f32_32x32x16_bf16(aVT[vb][0], bK0, Z16, 0, 0, 0); a = __builtin_amdgcn_mfma_f32_32x32x16_bf16(aVT[vb][1], bK1, a, 0, 0, 0);
            f32x16 s = __builtin_amdgcn_mfma_f32_32x32x16_bf16(aWv[vb][0], bB0, Z16, 0, 0, 0); s = __builtin_amdgcn_mfma_f32_32x32x16_bf16(aWv[vb][1], bB1, s, 0, 0, 0);
#pragma unroll
            for (int g = 0; g < 4; ++g) { const int v0 = 32 * vb + 8 * g + 4 * h; C1_ST4(1, t, v0, a[4 * g] - s[4 * g], a[4 * g + 1] - s[4 * g + 1], a[4 * g + 2] - s[4 * g + 2], a[4 * g + 3] - s[4 * g + 3]); } }
        C1_FLUSH(1, 4096 + jc * 2048); }
    LDS_WAIT(); asm volatile("" ::: "memory");
#undef C1_ROW
#undef C1_PUT
#undef C1_GETA
#undef C1_TR
#undef C1_ST4
#undef C1_FLUSH
}
__device__ __forceinline__ NOPK void c2_phase(Frame& F, const Args& A, int l) {
    const bf16* OPS = (const bf16*)(F.ws + WS_OPS); const bf16* CHB = (const bf16*)(F.ws + WS_CH); bf16* YC = (bf16*)(F.ws + WS_YCAT);
    constexpr int NSLOT = 5, SLOT_B = CH_ELEMS * 2, DEPTH_C = 4, PER_W = 12;
    LAS float* ybuf = (LAS float*)(F.lds + NSLOT * SLOT_B);
    static_assert(NSLOT * SLOT_B + 3 * 8192 <= MISC_OFF, "c2 LDS map");
    const int qi = F.lane & 31, hh = F.lane >> 5, vb32 = 32 * F.wave;
    const f32x16 Z16 = {0.f, 0.f, 0.f, 0.f, 0.f, 0.f, 0.f, 0.f, 0.f, 0.f, 0.f, 0.f, 0.f, 0.f, 0.f, 0.f};
    bf16x8 idn[2];
#pragma unroll
    for (int ks = 0; ks < 2; ++ks) { float f[8];
#pragma unroll
        for (int j = 0; j < 8; ++j) f[j] = (16 * ks + 8 * hh + j == qi) ? 1.0f : 0.f;
        idn[ks] = pack8(f); }
    const int pidx = (F.tid - 128) & 255, st = pidx >> 3, c8 = 8 * (pidx & 7); const bool loader = F.wave >= 6, chain = F.wave < 2;
    for (int bh = F.bid; bh < BATCH * NH; bh += F.G) {
        const int b = bh >> 3, h = bh & 7;
        if (chain) {
            f32x16 S0 = Z16, S1 = Z16;
            LDS_BARRIER();
            for (int c = 0; c <= NCH; ++c) {
                if (c < NCH) {
                    const LAS bf16* sl = (const LAS bf16*)(F.lds + (c % NSLOT) * SLOT_B);
#define C2_GETP(OFF, ROW, ks) ({ const u32x2 lo_ = *(const LAS u32x2*)(sl + (OFF) + (ROW) * 64 + CH_SWZ(ROW, 16 * (ks) + 4 * hh)), hi_ = *(const LAS u32x2*)(sl + (OFF) + (ROW) * 64 + CH_SWZ(ROW, 16 * (ks) + 8 + 4 * hh)); \
                        const u32x4 w_ = {lo_.x, lo_.y, hi_.x, hi_.y}; __builtin_bit_cast(bf16x8, w_); })
#define C2_GETN(OFF, ROW, ks) (*(const LAS bf16x8*)(sl + (OFF) + (ROW) * 64 + CH_SWZ(ROW, vb32 + 16 * (ks) + 8 * hh)))
                    bf16x8 sf[4]; sf[0] = acc_frag(S0, 0); sf[1] = acc_frag(S0, 1); sf[2] = acc_frag(S1, 0); sf[3] = acc_frag(S1, 1);
                    f32x16 Y = Z16, N0 = Z16, N1 = Z16;
#pragma unroll
                    for (int ks = 0; ks < 2; ++ks) { Y = __builtin_amdgcn_mfma_f32_32x32x16_bf16(C2_GETN(10240, qi, ks), idn[ks], Y, 0, 0, 0); N0 = __builtin_amdgcn_mfma_f32_32x32x16_bf16(C2_GETN(4096, qi, ks), idn[ks], N0, 0, 0, 0);
                                                    N1 = __builtin_amdgcn_mfma_f32_32x32x16_bf16(C2_GETN(4096, 32 + qi, ks), idn[ks], N1, 0, 0, 0); }
#pragma unroll
                    for (int ks = 0; ks < 4; ++ks) { Y = __builtin_amdgcn_mfma_f32_32x32x16_bf16(C2_GETP(8192, qi, ks), sf[ks], Y, 0, 0, 0);
                        N0 = __builtin_amdgcn_mfma_f32_32x32x16_bf16(C2_GETP(0, qi, ks), sf[ks], N0, 0, 0, 0); N1 = __builtin_amdgcn_mfma_f32_32x32x16_bf16(C2_GETP(0, 32 + qi, ks), sf[ks], N1, 0, 0, 0); }
                    LAS float* yb = ybuf + (c % 3) * 2048;
#pragma unroll
                    for (int i = 0; i < 16; ++i) { const int row = (i & 3) + 8 * (i >> 2) + 4 * hh; yb[row * 64 + vb32 + qi] = Y[i]; }
                    S0 = N0; S1 = N1;
#undef C2_GETP
#undef C2_GETN
                }
                LDS_BARRIER();
            }
            LDS_BARRIER();
        } else if (loader) {
#define C2_DMA(cidx) do { const bf16* ch_ = CHB + ((size_t)bh * NCH + (cidx)) * CH_ELEMS; LAS unsigned char* sl_ = F.lds + ((cidx) % NSLOT) * SLOT_B; \
            _Pragma("unroll") for (int k_ = 0; k_ < PER_W; ++k_) { const int i_ = (F.wave - 6) + 2 * k_; \
                __builtin_amdgcn_global_load_lds((const unsigned*)(ch_ + i_ * 512 + F.lane * 8), (LAS unsigned*)(sl_ + i_ * 1024), 16, 0, 0); } } while (0)
#pragma unroll 1
            for (int cc = 0; cc < DEPTH_C; ++cc) C2_DMA(cc);
            asm volatile("s_waitcnt vmcnt(36)" ::: "memory");
            LDS_BARRIER();
            for (int c = 0; c <= NCH; ++c) {
                if (c + DEPTH_C < NCH) { C2_DMA(c + DEPTH_C); asm volatile("s_waitcnt vmcnt(36)" ::: "memory"); }
                else if (c + 3 < NCH) asm volatile("s_waitcnt vmcnt(24)" ::: "memory");
                else if (c + 2 < NCH) asm volatile("s_waitcnt vmcnt(12)" ::: "memory");
                else asm volatile("s_waitcnt vmcnt(0)" ::: "memory");
                LDS_BARRIER();
            }
            LDS_BARRIER();
#undef C2_DMA
        } else {
            float plw[8], plb[8]; const float* BON = (const float*)(F.ws + WS_BON);
            ld8f(A.in[I_LNW] + (size_t)l * DR + 64 * h + c8, plw); ld8f(A.in[I_LNB] + (size_t)l * DR + 64 * h + c8, plb);
            u32x4 pv, pg, qv, qg; float pb = 0.f, qb = 0.f;
            LDS_BARRIER();
            for (int c = 0; c <= NCH; ++c) {
                if (c < NCH) { const bf16* op = OPS + ((size_t)bh * SEQ + c * CL) * 448 + (st >> 4) * 7168 + (c8 >> 5) * 512 + (st & 15) * 32 + (c8 & 31);
                    qv = *(const u32x4*)(op + 3 * 1024); qg = *(const u32x4*)(op + 6 * 1024); qb = BON[(size_t)bh * SEQ + c * CL + st]; }
                LDS_BARRIER();
                if (c > 0) {
                    const int cc = c - 1; const LAS float* yb = ybuf + (cc % 3) * 2048;
                    float y[8], v8[8], g8[8]; lds8f(yb + st * 64 + c8, y); unpack8(pv, v8); unpack8(pg, g8);
                    float s_ = 0.f;
#pragma unroll
                    for (int i = 0; i < 8; ++i) s_ += y[i];
                    const float mean = red8(s_) * (1.0f / 64.0f); float q = 0.f;
#pragma unroll
                    for (int i = 0; i < 8; ++i) { y[i] -= mean; q += y[i] * y[i]; }
                    const float rstd = 1.0f / sqrtf(red8(q) * (1.0f / 64.0f) + GN_EPS); const float bon = pb;
#pragma unroll
                    for (int i = 0; i < 8; ++i) y[i] = (y[i] * rstd * plw[i] + plb[i] + bon * v8[i]) * g8[i];
                    *(u32x4*)(YC + ((size_t)b * SEQ + cc * CL + st) * D + 64 * h + c8) = __builtin_bit_cast(u32x4, pack8(y));
                }
                pv = qv; pg = qg; pb = qb;
            }
            LDS_BARRIER();
        }
    }
}
__device__ __forceinline__ NOPK void c1a_phase(Frame& F, const Args& A, int l) {
    if (F.wave < 4) {
        LAS unsigned char* wl = F.lds + F.wave * C1_LDS;
        const int gw = F.bid * 4 + F.wave, NGW = F.G * 4;
        for (int u = gw; u < BATCH * NH * NCH; u += NGW) c1_unit(F, l, u >> 6, u & 63, wl);
    } else {
        attn_waves(F, A, l, F.bid * 4 + (F.wave - 4), F.G * 4);
    }
}

__global__ void __launch_bounds__(512, 2) NOPK mk_fwd(Args args) {
    extern __shared__ __attribute__((aligned(16))) unsigned char lds_raw[];
    Frame F;
    F.lds = (LAS unsigned char*)lds_raw;
    const int wave_s = __builtin_amdgcn_readfirstlane((int)threadIdx.x >> 6);
#define TID_NOW() ({ unsigned m_ = ~0u; asm volatile("" : "+s"(m_)); wave_s * 64 + (int)__builtin_amdgcn_mbcnt_hi(m_, __builtin_amdgcn_mbcnt_lo(m_, 0u)); })
    F.tid = TID_NOW(); F.lane = F.tid & 63; F.wave = wave_s; F.G = gridDim.x; F.bid = blockIdx.x;
    F.out = args.out; F.ws = args.ws;
    volatile LAS unsigned* MISC = (volatile LAS unsigned*)(F.lds + MISC_OFF);
    if (F.tid < 64) MISC[F.tid] = 0u;
    __syncthreads();
    const int lo = args.ph_lo, hi = args.ph_hi;
    unsigned* barw = (unsigned*)(F.ws + WS_CTL) + CW_BAR;
    XcdBarrier bar; bar.bar = barw; bar.x = 0; bar.st = nullptr;
    if (hi - lo > 1) bar = xcd_barrier_post(barw, MISC + 8, F.tid);
#define IN(k) (lo <= (k) && (k) < hi)
#define FRESH() do { F.tid = TID_NOW(); asm volatile("" : "+v"(F.tid)); F.lane = F.tid & 63; F.wave = wave_s; } while (0)
#define SEAM(k) do { if (IN(k) && IN((k) + 1)) { FRESH(); xcd_barrier(bar, F.tid); } } while (0)
constexpr int WGM_IN = 4, WGM_OUT = 8;
#ifndef PROBE_DUP
#define PROBE_DUP -1
#endif
#define SITE(k, ...) do { if (IN(k)) { __VA_ARGS__ if constexpr (PROBE_DUP >= 0) { if (PROBE_DUP == (k)) { __syncthreads(); __VA_ARGS__ } } } } while (0)
#define SITE2(k, code, ...) do { if (IN(k)) { __VA_ARGS__ if constexpr (PROBE_DUP >= 0) { if (PROBE_DUP == (code)) { __syncthreads(); __VA_ARGS__ } } } } while (0)
    SITE(0, FRESH(); p0_prologue(F, args);); SEAM(0);
    for (int l = 0; l < DEPTH; ++l) {
        const int p = 1 + 9 * l;
        SITE(p + 0, FRESH(); if (l == 0) norm_phase<0>(F, args, 0); else norm_phase<1>(F, args, 1);); SEAM(p + 0);
        SITE(p + 1,
            { FRESH(); pg8::Gemm g{(const bf16*)(F.ws + WS_H), (const bf16*)(F.ws + WS_WIN) + (size_t)l * C_IN * D, D}; pg8::StaticOrder<WGM_IN> S; S.init(M, C_IN, F.G, F.bid);
            pg8::EpiBf16 E{(bf16*)(F.ws + WS_Z), C_IN};
            pg8::gemm_phase<pg8::EpiBf16, pg8::StaticOrder<WGM_IN>, false>(F.lds, g, S, E, F.tid); }); SEAM(p + 1);
        SITE(p + 2, FRESH(); prep_phase(F, args, l);); SEAM(p + 2);
        SITE(p + 3, FRESH(); c1a_phase(F, args, l);); SEAM(p + 3);
        SITE(p + 4, FRESH(); c2_phase(F, args, l);); SEAM(p + 4);
        SITE(p + 5,
            { FRESH(); pg8::Gemm g{(const bf16*)(F.ws + WS_YCAT), (const bf16*)(F.ws + WS_WOUT) + (size_t)l * D * D, D}; pg8::StaticOrder<WGM_OUT> S; S.init(M, D, F.G, F.bid);
            pg8::EpiResid E{l == 0 ? args.in[I_X] : F.out, (bf16*)(F.ws + WS_X1), (const float*)(F.ws + WS_MOD) + (size_t)l * 32 * 6144 + 2048};
            pg8::gemm_phase<pg8::EpiResid, pg8::StaticOrder<WGM_OUT>, false>(F.lds, g, S, E, F.tid); }); SEAM(p + 5);
        SITE(p + 6, FRESH(); n2r_phase(F, args, l););
        if constexpr (PROBE_DUP == 6) { if (l == 0 && IN(p + 6)) { xcd_barrier(bar, F.tid); if (F.bid == 0 && F.tid < 32) ((unsigned*)(F.ws + WS_CTL))[CW_CNT + F.tid] = 0u; xcd_barrier(bar, F.tid); FRESH(); n2r_phase(F, args, l); } }
        SEAM(p + 6);
        SITE(p + 7,
            { FRESH(); build_tab(F, l);
            pg8::Gemm g{(const bf16*)(F.ws + WS_H), (const bf16*)(F.ws + WS_W1 + (size_t)l * NE * 2048 * D), D / 2};
            pg8::MoeOrder<8> S; S.init((const LAS int*)(F.lds + TAB_OFF), (const int*)(F.ws + WS_ROWTOK), F.G, F.bid, D);
            pg8::EpiSwiglu E{F.ws + WS_ACT, args.in[I_B1] + (size_t)l * NE * 2048};
            pg8::gemm_phase<pg8::EpiSwiglu, pg8::MoeOrder<8>, true, true>(F.lds, g, S, E, F.tid); }); SEAM(p + 7);
        SITE(p + 8,
            { FRESH(); build_tab(F, l);
            pg8::Gemm g{(const bf16*)(F.ws + WS_ACT), (const bf16*)(F.ws + WS_W2 + (size_t)l * NE * D * FF), FF / 2};
            pg8::MoeOrder<4, true> S; S.init((const LAS int*)(F.lds + TAB_OFF), (const int*)(F.ws + WS_ROWTOK), F.G, F.bid, FF);
            pg8::EpiY E{F.ws + WS_Y, args.in[I_B2] + (size_t)l * NE * D};
            pg8::gemm_phase<pg8::EpiY, pg8::MoeOrder<4, true>, true, true>(F.lds, g, S, E, F.tid); }); SEAM(p + 8);
    }
    SITE(19, FRESH(); norm_phase<2>(F, args, 1););
#undef IN
#undef SEAM
}

extern "C" void kernel_launch(void* const* d_in, const int* in_sizes, int n_in, void* d_out, int out_size, void* d_ws, size_t ws_size, hipStream_t stream) {
    static int grid = 0;
    if (grid == 0) {
        if (n_in != N_IN || in_sizes[0] != M * D || out_size != M * D || ws_size < WS_END) { fprintf(stderr, "kernel_launch: unexpected shapes (n_in %d, in0 %d, out %d, ws %zu)\n", n_in, n_in > 0 ? in_sizes[0] : -1, out_size, ws_size); grid = -1; return; }
        int dev = 0, cus = 0, per_cu = 0;
        if (hipGetDevice(&dev) != hipSuccess || hipDeviceGetAttribute(&cus, hipDeviceAttributeMultiprocessorCount, dev) != hipSuccess) { grid = -1; return; }
        if (hipFuncSetAttribute((const void*)mk_fwd, hipFuncAttributeMaxDynamicSharedMemorySize, LDS_BYTES) != hipSuccess) { fprintf(stderr, "kernel_launch: hipFuncSetAttribute failed\n"); grid = -1; return; }
        if (hipOccupancyMaxActiveBlocksPerMultiprocessor(&per_cu, (const void*)mk_fwd, 512, LDS_BYTES) != hipSuccess || per_cu < 1) fprintf(stderr, "kernel_launch: occupancy query says %d\n", per_cu);
        (void)hipGetLastError();
        grid = cus;
    }
    if (grid < 0) return;
    (void)hipMemsetAsync((char*)d_ws + WS_CTL, 0, CTL_ZERO_BYTES, stream);
    Args a{};
    for (int i = 0; i < N_IN; ++i) a.in[i] = (const float*)d_in[i];
    a.out = (float*)d_out; a.ws = (unsigned char*)d_ws;
#if MK_N_LAUNCHES == 1
    a.ph_lo = 0; a.ph_hi = NPH;
    hipLaunchKernelGGL(mk_fwd, dim3(grid), dim3(512), LDS_BYTES, stream, a);
#else
    for (int ph = 0; ph < NPH; ++ph) { a.ph_lo = ph; a.ph_hi = ph + 1; hipLaunchKernelGGL(mk_fwd, dim3(grid), dim3(512), LDS_BYTES, stream, a); }
#endif
}
```
